# Optimizing an MI355X kernel written in HIP

```python
import jax, jax.numpy as jnp
from jax import lax
import numpy as np

D_MODEL = 4096
BATCH = 4
SEQ = 2048
DEPTH = 2

GRID_W = 64
CTX_LEN = 256
N_MIXERS = 2
N_LAYERS_A = (DEPTH + 1) // 2
N_LAYERS_B = DEPTH // 2
NA_HEADS = 32
NA_HEAD_DIM = D_MODEL // NA_HEADS
NA_KH_MAX = 8
NA_KW = 16
RPB_H = 2 * NA_KH_MAX - 1
RPB_W = 2 * NA_KW - 1
SG_CHUNK = 128
SG_WIDTH = D_MODEL
SG_GROUPS = 8
SG_GROUP_DIM = SG_WIDTH // SG_GROUPS
D_FF = 2 * D_MODEL
N_FFN = 2
N_SUB = 3
N_MOD = 3 * N_SUB
EPS = 1e-6
NEG_INF = -1e30

kernel_name = "hybrid_natten_gmlp_macaron_dit"


def rms_norm(x, gain):
    xf = x.astype(jnp.float32)
    y = xf * lax.rsqrt(jnp.mean(xf * xf, axis=-1, keepdims=True) + EPS)
    return (y * gain.astype(jnp.float32)).astype(x.dtype)


def modulate(x, gain, mod, j):
    return rms_norm(x, gain) * (1 + mod[:, 3 * j + 1]) + mod[:, 3 * j]


def swiglu(h, w_in, w_out):
    a, g = jnp.split(h @ w_in, 2, axis=-1)
    return (jax.nn.silu(a) * g) @ w_out


def half_ffn(x, gain, mod, j, w_in, w_out):
    h = modulate(x, gain, mod, j)
    return x + 0.5 * mod[:, 3 * j + 2] * swiglu(h, w_in, w_out)


def neighbourhood_attention(h_lat, h_ctx, w_qkv, w_o, q_gain, k_gain, rpb, with_ctx_out):
    B, S, _ = h_lat.shape
    rows = S // GRID_W
    kh = min(NA_KH_MAX, rows)
    scale = NA_HEAD_DIM ** -0.5

    def project(h):
        qkv = (h @ w_qkv).reshape(h.shape[0], h.shape[1], 3, NA_HEADS, NA_HEAD_DIM)
        q = rms_norm(qkv[:, :, 0], q_gain) * scale
        k = rms_norm(qkv[:, :, 1], k_gain)
        return q, k, qkv[:, :, 2]

    q, k, v = project(h_lat)
    qc, kc, vc = project(h_ctx)

    def to_grid(t):
        return t.reshape(B, rows, GRID_W, NA_HEADS, NA_HEAD_DIM).transpose(1, 0, 3, 2, 4)

    q_g, k_g, v_g = to_grid(q), to_grid(k), to_grid(v)

    col = jnp.arange(GRID_W)
    cs = jnp.clip(col - NA_KW // 2, 0, GRID_W - NA_KW)
    col_ok = (col[None, :] >= cs[:, None]) & (col[None, :] < cs[:, None] + NA_KW)
    dc = jnp.clip(col[None, :] - col[:, None], -(NA_KW - 1), NA_KW - 1) + NA_KW - 1
    rpb_cols = rpb[:, :, dc]
    r_all = jnp.arange(rows)
    rs = jnp.clip(r_all - kh // 2, 0, rows - kh)
    n_lat = kh * GRID_W

    def row_block(args):
        q_r, r, r0 = args
        k_r = lax.dynamic_slice_in_dim(k_g, r0, kh, axis=0)
        v_r = lax.dynamic_slice_in_dim(v_g, r0, kh, axis=0)
        dr = r0 + jnp.arange(kh) - r + NA_KH_MAX - 1
        bias = jnp.take(rpb_cols, dr, axis=1).transpose(0, 2, 1, 3)
        s_lat = jnp.einsum('bhqd,ibhkd->bhqik', q_r, k_r).astype(jnp.float32)
        s_lat = s_lat + bias[None].astype(jnp.float32)
        s_lat = jnp.where(col_ok[:, None, :], s_lat, NEG_INF)
        s_ctx = jnp.einsum('bhqd,bchd->bhqc', q_r, kc).astype(jnp.float32)
        s = jnp.concatenate([s_lat.reshape(B, NA_HEADS, GRID_W, n_lat), s_ctx], axis=-1)
        p = jax.nn.softmax(s, axis=-1).astype(v.dtype)
        p_lat = p[..., :n_lat].reshape(B, NA_HEADS, GRID_W, kh, GRID_W)
        o = (jnp.einsum('bhqik,ibhkd->bqhd', p_lat, v_r)
             + jnp.einsum('bhqc,bchd->bqhd', p[..., n_lat:], vc))
        return o

    o_lat = lax.map(row_block, (q_g, r_all, rs))
    o_lat = o_lat.transpose(1, 0, 2, 3, 4).reshape(B, S, D_MODEL) @ w_o

    o_ctx = None
    if with_ctx_out:
        C = h_ctx.shape[1]
        s_c = jnp.einsum('bqhd,bkhd->bhqk', qc, kc).astype(jnp.float32)
        p_c = jax.nn.softmax(s_c, axis=-1).astype(vc.dtype)
        o_ctx = jnp.einsum('bhqk,bkhd->bqhd', p_c, vc).reshape(B, C, D_MODEL) @ w_o
    return o_lat, o_ctx


def spatial_gating(h, w_in, b_in, v_gain, w_s, b_s, w_out):
    B, L, _ = h.shape
    u, v = jnp.split(jax.nn.gelu(h @ w_in + b_in), 2, axis=-1)
    v = rms_norm(v, v_gain).reshape(B, L // SG_CHUNK, SG_CHUNK, SG_GROUPS, SG_GROUP_DIM)
    mixed = jnp.einsum('gpq,bnqgc->bnpgc', w_s, v) + b_s.T[None, None, :, :, None]
    return (u * mixed.reshape(B, L, SG_WIDTH)) @ w_out


def setup_inputs(seed: int = 0) -> dict:
    key = jax.random.key(seed)
    ks = jax.random.split(key, 20)

    def nrm(k, shape, s):
        return jax.random.normal(k, shape, jnp.float32) * s

    D = D_MODEL
    return {
        "x": nrm(ks[0], (BATCH, SEQ, D), 1.0),
        "c": nrm(ks[1], (BATCH, D), 1.0),
        "ctx": nrm(ks[2], (BATCH, CTX_LEN, D), 1.0),
        "c_ctx": nrm(ks[3], (D,), 1.0),
        "w_ada": nrm(ks[4], (DEPTH, D, N_MOD * D), 0.5 * D ** -0.5),
        "b_ada": nrm(ks[5], (DEPTH, N_MOD * D), 0.02),
        "norm_g": 1.0 + nrm(ks[6], (DEPTH, N_SUB, D), 0.02),
        "ffn_w_in": nrm(ks[7], (DEPTH, N_FFN, D, 2 * D_FF), D ** -0.5),
        "ffn_w_out": nrm(ks[8], (DEPTH, N_FFN, D_FF, D), D_FF ** -0.5),
        "na_w_qkv": nrm(ks[9], (N_LAYERS_A, D, 3 * D), D ** -0.5),
        "na_w_o": nrm(ks[10], (N_LAYERS_A, D, D), D ** -0.5),
        "na_q_gain": 1.0 + nrm(ks[11], (N_LAYERS_A, NA_HEAD_DIM), 0.02),
        "na_k_gain": 1.0 + nrm(ks[12], (N_LAYERS_A, NA_HEAD_DIM), 0.02),
        "na_rpb": nrm(ks[13], (N_LAYERS_A, NA_HEADS, RPB_H, RPB_W), 0.5),
        "sg_w_in": nrm(ks[14], (N_LAYERS_B, D, 2 * SG_WIDTH), D ** -0.5),
        "sg_b_in": nrm(ks[15], (N_LAYERS_B, 2 * SG_WIDTH), 0.02),
        "sg_v_gain": 1.0 + nrm(ks[16], (N_LAYERS_B, SG_WIDTH), 0.02),
        "sg_w_s": nrm(ks[17], (N_LAYERS_B, SG_GROUPS, SG_CHUNK, SG_CHUNK), SG_CHUNK ** -0.5),
        "sg_b_s": 1.0 + nrm(ks[18], (N_LAYERS_B, SG_GROUPS, SG_CHUNK), 0.02),
        "sg_w_out": nrm(ks[19], (N_LAYERS_B, SG_WIDTH, D), SG_WIDTH ** -0.5),
    }


def reference(x, c, ctx, c_ctx, w_ada, b_ada, norm_g, ffn_w_in, ffn_w_out,
              na_w_qkv, na_w_o, na_q_gain, na_k_gain, na_rpb,
              sg_w_in, sg_b_in, sg_v_gain, sg_w_s, sg_b_s, sg_w_out):
    B = x.shape[0]
    z = ctx
    for i in range(DEPTH):
        kind = i % N_MIXERS
        j = i // N_MIXERS
        keep_ctx = i < DEPTH - 1
        ctx_in = keep_ctx or kind == 0
        m_x = (jax.nn.silu(c) @ w_ada[i] + b_ada[i]).reshape(B, N_MOD, 1, D_MODEL)
        m_z = (jax.nn.silu(c_ctx)[None] @ w_ada[i] + b_ada[i]).reshape(1, N_MOD, 1, D_MODEL)

        x = half_ffn(x, norm_g[i, 0], m_x, 0, ffn_w_in[i, 0], ffn_w_out[i, 0])
        if ctx_in:
            z = half_ffn(z, norm_g[i, 0], m_z, 0, ffn_w_in[i, 0], ffn_w_out[i, 0])

        hx = modulate(x, norm_g[i, 1], m_x, 1)
        if kind == 0:
            hz = modulate(z, norm_g[i, 1], m_z, 1)
            ox, oz = neighbourhood_attention(hx, hz, na_w_qkv[j], na_w_o[j], na_q_gain[j],
                                             na_k_gain[j], na_rpb[j], keep_ctx)
        else:
            sg = (sg_w_in[j], sg_b_in[j], sg_v_gain[j], sg_w_s[j], sg_b_s[j], sg_w_out[j])
            ox = spatial_gating(hx, *sg)
            oz = spatial_gating(modulate(z, norm_g[i, 1], m_z, 1), *sg) if keep_ctx else None
        x = x + m_x[:, 5] * ox

        x = half_ffn(x, norm_g[i, 2], m_x, 2, ffn_w_in[i, 1], ffn_w_out[i, 1])
        if keep_ctx:
            z = z + m_z[:, 5] * oz
            z = half_ffn(z, norm_g[i, 2], m_z, 2, ffn_w_in[i, 1], ffn_w_out[i, 1])
    return x
```

```cpp
#include <hip/hip_runtime.h>
#include <cstdio>
#include <cstdint>
#ifndef PG8_WGM
#define PG8_WGM 8
#endif
#ifndef GK_ALIGN
#define GK_ALIGN true
#endif
#ifndef PG8_FRESH
#define PG8_FRESH 0
#endif
#ifndef GK_SP2
#define GK_SP2 true
#endif
namespace pg8 {
#define PG8_LAS __attribute__((address_space(3)))
typedef unsigned short bf16_t;
typedef short bf16x8 __attribute__((ext_vector_type(8)));
typedef float f32x4 __attribute__((ext_vector_type(4)));
typedef unsigned u32x4 __attribute__((ext_vector_type(4)));
constexpr int BM = 256, BK = 64, HALF = 128, HTB = HALF * BK * 2  , STAGE_BYTES = 8 * HTB, NXCD = 8, WGM = PG8_WGM;

__host__ __device__ __forceinline__ int lds_byte(int r, int c) { const int st = (r >> 4) * 2 + (c >> 5), rr = r & 15, cc = c & 31, ob = rr * 64 + cc * 2; return st * 1024 + (ob ^ (((ob >> 9) & 1) << 5)); }
__host__ __device__ __forceinline__ void stage_rc(int b, int& R, int& C) { const int st = b / 1024, sb = b % 1024, swz = sb ^ (((sb >> 9) & 1) << 5); R = (st >> 1) * 16 + swz / 64; C = (st & 1) * 32 + (swz % 64) / 2; }
__host__ __device__ __forceinline__ int perm32(int rho) { const int n = rho >> 4, i = rho & 15; return 8 * (i >> 2) + 4 * n + (i & 3); }

struct Unit { int pm, pn, ko; };
struct Gemm { const bf16_t* A; const bf16_t* Bt; int M, N, K, ld; };

struct StaticOrder {
    int nM, nN, nwg, G, c;
    __host__ __device__ void init(int M, int N, int G_, int c_) { nM = M / BM; nN = N / BM; nwg = nM * nN; G = G_; c = c_; }
    __host__ __device__ bool next(int i, Unit& u) const {
        const long L = (long)i * G + c; if (L >= nwg) return false;
        int wgid = (int)L; { const int q = nwg / NXCD, r = nwg % NXCD, xcd = wgid % NXCD, off = wgid / NXCD; wgid = (xcd < r ? xcd * (q + 1) : r * (q + 1) + (xcd - r) * q) + off; }
        const int nig = WGM * nN, gid = wgid / nig, fm = gid * WGM, gsz = (nM - fm) < WGM ? (nM - fm) : WGM;
        u.pm = fm + ((wgid % nig) % gsz); u.pn = (wgid % nig) / gsz; u.ko = 0; return true;
    }
    __device__ __forceinline__ void a_ready(const Unit&) const {}
    __device__ __forceinline__ void done(const Unit&) const {}
};
struct QkvOrder {
    StaticOrder base; int nx;
    __host__ __device__ void init(int G_, int c_) { base.init(8192, 12288, G_, c_); nx = base.nwg; }
    __host__ __device__ bool next(int i, Unit& u) const {
        const long L = (long)i * base.G + base.c; if (L < nx) return base.next(i, u);
        const int l2 = (int)(L - nx); if (l2 >= 128) return false; u.pm = 32 + (l2 & 3); u.pn = 16 + (l2 >> 2); u.ko = 0; return true;
    }
    __device__ __forceinline__ void a_ready(const Unit&) const {}
    __device__ __forceinline__ void done(const Unit&) const {}
};
struct SameTileOrder {
    StaticOrder base;
    __host__ __device__ void init(int M, int N, int G_, int c_) { base.init(M, N, G_, c_); }
    __host__ __device__ bool next(int i, Unit& u) const { const bool ok = base.next(i, u); u.pm = 0; u.pn = 0; return ok; }
    __device__ __forceinline__ void a_ready(const Unit&) const {}
    __device__ __forceinline__ void done(const Unit&) const {}
};
struct ZSplitOrder {
    int G, c;
    __host__ __device__ void init(int G_, int c_) { G = G_; c = c_; }
    __host__ __device__ bool next(int i, Unit& u) const { const int s = i * G + c; if (s >= 256) return false; u.pm = 32 + ((s >> 2) & 3); u.pn = s >> 4; u.ko = (s & 3) * 2048 * 2; return true; }
    __device__ __forceinline__ void a_ready(const Unit&) const {}
    __device__ __forceinline__ void done(const Unit&) const {}
};

__device__ __forceinline__ unsigned cvt_pk_bf16(float lo, float hi) { unsigned r; asm volatile("v_cvt_pk_bf16_f32 %0, %1, %2" : "=v"(r) : "v"(lo), "v"(hi)); return r; }
__device__ __forceinline__ int lane_fresh() { int l; asm volatile("v_mbcnt_lo_u32_b32 %0, -1, 0\n\tv_mbcnt_hi_u32_b32 %0, -1, %0" : "=v"(l)); return l; }
typedef float f32x2 __attribute__((ext_vector_type(2)));
typedef unsigned u32x2 __attribute__((ext_vector_type(2)));
#define PG8_GAS __attribute__((address_space(1)))
#ifndef PROBE_EPI2
#define PROBE_EPI2 false
#endif

struct EpiBf16 {
    static constexpr bool PERM = true, AFTER_DRAIN = false, TWICE = false;
    bf16_t* O; int ldc;
    __device__ __forceinline__ void operator()(const f32x4 (&acc)[2][2][4][2], const Unit& u, int wr, int wc, int fr, int fq) const {
        const int row0 = u.pm * BM + wr * 64 + fr, col0 = u.pn * BM + wc * 32 + 8 * fq;
#pragma unroll
        for (int ai = 0; ai < 2; ++ai)
#pragma unroll
            for (int m = 0; m < 4; ++m) { bf16_t* rowp = O + (size_t)(row0 + ai * HALF + m * 16) * ldc + col0;
#pragma unroll
                for (int bj = 0; bj < 2; ++bj) { const f32x4 v0 = acc[ai][bj][m][0], v1 = acc[ai][bj][m][1];
                    u32x4 w; w.x = cvt_pk_bf16(v0[0], v0[1]); w.y = cvt_pk_bf16(v0[2], v0[3]); w.z = cvt_pk_bf16(v1[0], v1[1]); w.w = cvt_pk_bf16(v1[2], v1[3]);
                    *(PG8_GAS u32x4*)(rowp + bj * HALF) = w; } }
    }
};

__device__ __forceinline__ float silu_mul(float a, float g) { const float e = __builtin_amdgcn_exp2f(a * -1.4426950408889634f); return a * g * __builtin_amdgcn_rcpf(1.0f + e); }
struct EpiSwiGLU {
    static constexpr bool PERM = true, AFTER_DRAIN = false, TWICE = PROBE_EPI2;
    bf16_t* O; int ldc;
    __device__ __forceinline__ void operator()(const f32x4 (&acc)[2][2][4][2], const Unit& u, int wr, int wc, int fr, int fq) const {
        const int row0 = u.pm * BM + wr * 64 + fr, col0 = u.pn * HALF + wc * 32 + 8 * fq;
#pragma unroll
        for (int ai = 0; ai < 2; ++ai)
#pragma unroll
            for (int m = 0; m < 4; ++m) { bf16_t* rowp = O + (size_t)(row0 + ai * HALF + m * 16) * ldc + col0;
                const f32x4 a0 = acc[ai][0][m][0], a1 = acc[ai][0][m][1], g0 = acc[ai][1][m][0], g1 = acc[ai][1][m][1];
                u32x4 w; w.x = cvt_pk_bf16(silu_mul(a0[0], g0[0]), silu_mul(a0[1], g0[1])); w.y = cvt_pk_bf16(silu_mul(a0[2], g0[2]), silu_mul(a0[3], g0[3]));
                w.z = cvt_pk_bf16(silu_mul(a1[0], g1[0]), silu_mul(a1[1], g1[1])); w.w = cvt_pk_bf16(silu_mul(a1[2], g1[2]), silu_mul(a1[3], g1[3]));
                *(PG8_GAS u32x4*)rowp = w; }
    }
};

template <size_t O_XS, size_t O_MOD, size_t O_XG, size_t O_SSQ, int GSLOT, int GS2, size_t O_NG, size_t O_NMOD, int NSLOT, bool HAS_XG>
struct EpiResid {
    static constexpr bool PERM = true, AFTER_DRAIN = false, TWICE = false;
    unsigned char* ws;
    const float* rin; float* out;
    __device__ __forceinline__ void operator()(const f32x4 (&acc)[2][2][4][2], const Unit& u, int wr, int wc, int fr, int fq) const {
        unsigned long long w_ = (unsigned long long)ws; asm volatile("" : "+s"(w_));
        unsigned char* wsp = (unsigned char*)w_;
        float* xsx = (float*)(wsp + O_XS);
        const int bidx = u.pm >> 3;
        const int lrow0 = u.pm * BM + wr * 64 + fr, col0 = u.pn * BM + wc * 32 + 8 * fq, grow0 = u.pm * BM + wr * 64 + fr;
        const PG8_GAS float* ri = (const PG8_GAS float*)(rin ? rin : xsx); PG8_GAS float* ro = (PG8_GAS float*)(out ? out : xsx);
        const PG8_GAS float* gp = (const PG8_GAS float*)(wsp + O_MOD) + (size_t)bidx * 36864 + GSLOT * 4096 + col0;
        PG8_GAS bf16_t* xg = (PG8_GAS bf16_t*)(wsp + O_XG); PG8_GAS float* ssq = (PG8_GAS float*)(wsp + O_SSQ);
        f32x4 gv[2][2], nm[2][2], cur[2][2], nxt[2][2];
#pragma unroll
        for (int bj = 0; bj < 2; ++bj)
#pragma unroll
            for (int n = 0; n < 2; ++n) { gv[bj][n] = *(const PG8_GAS f32x4*)(gp + bj * HALF + n * 4) * (0.5f * GS2); cur[bj][n] = *(const PG8_GAS f32x4*)(ri + (size_t)lrow0 * 4096 + col0 + bj * HALF + n * 4);
                nm[bj][n] = (f32x4){0.f, 0.f, 0.f, 0.f};
                if (HAS_XG) { const f32x4 g_ = *(const PG8_GAS f32x4*)((const PG8_GAS float*)(wsp + O_NG) + col0 + bj * HALF + n * 4);
                    const f32x4 s_ = *(const PG8_GAS f32x4*)((const PG8_GAS float*)(wsp + O_NMOD) + (size_t)bidx * 36864 + NSLOT * 4096 + col0 + bj * HALF + n * 4); nm[bj][n] = g_ * (s_ + 1.0f); } }
#pragma unroll
        for (int g = 0; g < 8; ++g) { const int ai = g >> 2, m = g & 3; const size_t off = (size_t)(lrow0 + ai * HALF + m * 16) * 4096 + col0, goff = (size_t)(grow0 + ai * HALF + m * 16) * 4096 + col0; float ss = 0.f;
            if (g < 7) { const size_t offn = (size_t)(lrow0 + ((g + 1) >> 2) * HALF + ((g + 1) & 3) * 16) * 4096 + col0;
#pragma unroll
                for (int bj = 0; bj < 2; ++bj)
#pragma unroll
                    for (int n = 0; n < 2; ++n) nxt[bj][n] = *(const PG8_GAS f32x4*)(ri + offn + bj * HALF + n * 4); }
#pragma unroll
            for (int bj = 0; bj < 2; ++bj) { const f32x4 y0 = cur[bj][0] + gv[bj][0] * acc[ai][bj][m][0], y1 = cur[bj][1] + gv[bj][1] * acc[ai][bj][m][1];
                *(PG8_GAS f32x4*)(ro + off + bj * HALF) = y0; *(PG8_GAS f32x4*)(ro + off + bj * HALF + 4) = y1;
                if (HAS_XG) { ss += ((y0[0] * y0[0] + y0[1] * y0[1]) + (y0[2] * y0[2] + y0[3] * y0[3])) + ((y1[0] * y1[0] + y1[1] * y1[1]) + (y1[2] * y1[2] + y1[3] * y1[3]));
                    const f32x4 z0 = y0 * nm[bj][0], z1 = y1 * nm[bj][1]; u32x4 w; w.x = cvt_pk_bf16(z0[0], z0[1]); w.y = cvt_pk_bf16(z0[2], z0[3]); w.z = cvt_pk_bf16(z1[0], z1[1]); w.w = cvt_pk_bf16(z1[2], z1[3]);
                    *(PG8_GAS u32x4*)(xg + goff + bj * HALF) = w; } }
            if (HAS_XG) { ss += __shfl_xor(ss, 16); ss += __shfl_xor(ss, 32);
                if (fq == 0) ssq[(size_t)(grow0 + ai * HALF + m * 16) * 64 + u.pn * 4 + wc] = ss; }
            asm volatile("" ::: "memory");
#pragma unroll
            for (int bj = 0; bj < 2; ++bj)
#pragma unroll
                for (int n = 0; n < 2; ++n) cur[bj][n] = nxt[bj][n]; }
    }
};

struct EpiPart {
    static constexpr bool PERM = false, AFTER_DRAIN = false, TWICE = false;
    float* P;
    __device__ __forceinline__ void operator()(const f32x4 (&acc)[2][2][4][2], const Unit& u, int wr, int wc, int fr, int fq) const {
        const int lrow0 = (u.pm - 32) * BM + wr * 64 + fr, col0 = u.pn * BM + wc * 32 + 4 * fq;
        PG8_GAS float* po = (PG8_GAS float*)P + (size_t)(u.ko >> 12) * 1024 * 4096;
#pragma unroll
        for (int ai = 0; ai < 2; ++ai)
#pragma unroll
            for (int m = 0; m < 4; ++m) { const size_t off = (size_t)(lrow0 + ai * HALF + m * 16) * 4096 + col0;
#pragma unroll
                for (int bj = 0; bj < 2; ++bj)
#pragma unroll
                    for (int n = 0; n < 2; ++n) *(PG8_GAS f32x4*)(po + off + bj * HALF + n * 16) = acc[ai][bj][m][n]; }
    }
};

__device__ __forceinline__ float gelu_tanh(float x) { const float t = x * (1.0f + 0.044715f * x * x) * -2.3022081918882205f;
    return x * __builtin_amdgcn_rcpf(1.0f + __builtin_amdgcn_exp2f(t)); }
struct EpiSG {
    static constexpr bool PERM = true, AFTER_DRAIN = false, TWICE = false;
    bf16_t* U; bf16_t* V; const float* bias; float* ssp;
    __device__ __forceinline__ void operator()(const f32x4 (&acc)[2][2][4][2], const Unit& u, int wr, int wc, int fr, int fq) const {
        const bool isv = u.pn >= 16; const int row0 = u.pm * BM + wr * 64 + fr, colt = (isv ? u.pn - 16 : u.pn) * BM, col0 = colt + wc * 32 + 8 * fq, bcol0 = u.pn * BM + wc * 32 + 8 * fq;
        bf16_t* base = isv ? V : U;
        f32x4 bv[2][2];
#pragma unroll
        for (int bj = 0; bj < 2; ++bj)
#pragma unroll
            for (int n = 0; n < 2; ++n) bv[bj][n] = *(const PG8_GAS f32x4*)((const PG8_GAS float*)bias + bcol0 + bj * HALF + 4 * n);
#pragma unroll
        for (int ai = 0; ai < 2; ++ai)
#pragma unroll
            for (int m = 0; m < 4; ++m) { bf16_t* rowp = base + (size_t)(row0 + ai * HALF + m * 16) * 4096 + col0; float ss = 0.f;
#pragma unroll
                for (int bj = 0; bj < 2; ++bj) { f32x4 v0 = acc[ai][bj][m][0] + bv[bj][0], v1 = acc[ai][bj][m][1] + bv[bj][1];
#pragma unroll
                    for (int j = 0; j < 4; ++j) { v0[j] = gelu_tanh(v0[j]); v1[j] = gelu_tanh(v1[j]); ss += v0[j] * v0[j] + v1[j] * v1[j]; }
                    u32x4 w; w.x = cvt_pk_bf16(v0[0], v0[1]); w.y = cvt_pk_bf16(v0[2], v0[3]); w.z = cvt_pk_bf16(v1[0], v1[1]); w.w = cvt_pk_bf16(v1[2], v1[3]);
                    *(PG8_GAS u32x4*)(rowp + bj * HALF) = w; }
                if (isv) { ss += __shfl_xor(ss, 16); ss += __shfl_xor(ss, 32);
                    if (fq == 0) ((PG8_GAS float*)ssp)[(size_t)(row0 + ai * HALF + m * 16) * 64 + (u.pn - 16) * 4 + wc] = ss; } }
    }
};

struct EpiNull {
    static constexpr bool PERM = true, AFTER_DRAIN = false, TWICE = false;
    int dummy;
    __device__ __forceinline__ void operator()(const f32x4 (&acc)[2][2][4][2], const Unit& u, int wr, int wc, int fr, int fq) const {
#pragma unroll
        for (int ai = 0; ai < 2; ++ai)
#pragma unroll
            for (int bj = 0; bj < 2; ++bj)
#pragma unroll
                for (int m = 0; m < 4; ++m)
#pragma unroll
                    for (int n = 0; n < 2; ++n) asm volatile("" :: "v"(acc[ai][bj][m][n]));
    }
};
template <class Epi, class Sched, bool ALIGN_EPI = false, bool SP2 = false>
__device__ __forceinline__ void gemm_phase(PG8_LAS unsigned char* lds, const Gemm g, const Sched& S, const Epi& E, const int tid) {
    const int wid = __builtin_amdgcn_readfirstlane(tid >> 6), lane = tid & 63, wr = wid >> 2, wc = wid & 3, fr = lane & 15, fq = lane >> 4;
    const int K = g.ld, nt = g.K / BK;
    unsigned voffA[2], voffB[2];
#pragma unroll
    for (int i = 0; i < 2; ++i) { int R, C; stage_rc(tid * 16 + i * 8192, R, C); const int Rb = Epi::PERM ? ((R & ~31) + perm32(R & 31)) : R;
        voffA[i] = (unsigned)(R * K + C) * 2u; voffB[i] = (unsigned)(Rb * K + C) * 2u; }
    const size_t kstep = (size_t)(BK * 2);
    const size_t hstep = (size_t)HALF * K * 2;
    const size_t tstep = 2 * hstep;
    const unsigned ldsw = (unsigned)wid * 1024u;
    const int aoff = lds_byte(wr * 64 + fr, fq * 8), boff = lds_byte(wc * 32 + fr, fq * 8);
#define PG8_SA(b, h) (((b) * 2 + (h)) * HTB)
#define PG8_SB(b, h) ((4 + (b) * 2 + (h)) * HTB)
#define PG8_STAGE(bufoff, gbase, voff) do { _Pragma("unroll") for (int _i = 0; _i < 2; ++_i) \
        __builtin_amdgcn_global_load_lds((const unsigned*)((const char*)(gbase) + (voff)[_i]), (PG8_LAS unsigned*)(lds + (bufoff) + ldsw + _i * 8192), 16, 0, 0); } while (0)
#define PG8_LDA(dst, b, h) do { _Pragma("unroll") for (int m = 0; m < 4; ++m) _Pragma("unroll") for (int k = 0; k < 2; ++k) dst[m][k] = *(const PG8_LAS bf16x8*)(lds + PG8_SA(b, h) + aoff + m * 2048 + k * 1024); } while (0)
#define PG8_LDB(dst, b, h) do { _Pragma("unroll") for (int n = 0; n < 2; ++n) _Pragma("unroll") for (int k = 0; k < 2; ++k) dst[n][k] = *(const PG8_LAS bf16x8*)(lds + PG8_SB(b, h) + boff + n * 2048 + k * 1024); } while (0)
#define PG8_MMA(ai, bj, At, Bt) do { __builtin_amdgcn_s_setprio(1); _Pragma("unroll") for (int m = 0; m < 4; ++m) _Pragma("unroll") for (int n = 0; n < 2; ++n) _Pragma("unroll") for (int k = 0; k < 2; ++k) \
        acc[ai][bj][m][n] = __builtin_amdgcn_mfma_f32_16x16x32_bf16(Bt[n][k], At[m][k], acc[ai][bj][m][n], 0, 0, 0); __builtin_amdgcn_s_setprio(0); } while (0)
#define PG8_WAIT_V(n) asm volatile("s_waitcnt vmcnt(" #n ")" ::: "memory")
#define PG8_WAIT_L(n) asm volatile("s_waitcnt lgkmcnt(" #n ")" ::: "memory")
#define PG8_BAR __builtin_amdgcn_s_barrier()
#define PG8_SCHED __builtin_amdgcn_sched_barrier(0)
    Unit cur, nxt; int ui = 0;
    if (!S.next(0, cur)) return;
    f32x4 acc[2][2][4][2];
#pragma unroll
    for (int a = 0; a < 2; ++a)
#pragma unroll
        for (int b = 0; b < 2; ++b)
#pragma unroll
            for (int m = 0; m < 4; ++m)
#pragma unroll
                for (int n = 0; n < 2; ++n) acc[a][b][m][n] = (f32x4){0.f, 0.f, 0.f, 0.f};
    bf16x8 At[4][2], B0[2][2], B1[2][2];
    const char* cA = (const char*)g.A + (size_t)cur.pm * tstep + cur.ko; const char* cB = (const char*)g.Bt + (size_t)cur.pn * tstep + cur.ko;
    S.a_ready(cur);
    if constexpr (SP2) {
        PG8_STAGE(PG8_SB(0, 0), cB, voffB); PG8_STAGE(PG8_SB(0, 1), cB + hstep, voffB); PG8_STAGE(PG8_SA(0, 0), cA, voffA); PG8_STAGE(PG8_SA(0, 1), cA + hstep, voffA);
        if (wr == 1) PG8_BAR;
        PG8_WAIT_V(2); PG8_BAR;
        PG8_STAGE(PG8_SB(1, 0), cB + kstep, voffB); PG8_STAGE(PG8_SA(1, 0), cA + kstep, voffA); PG8_STAGE(PG8_SB(1, 1), cB + hstep + kstep, voffB);
        PG8_WAIT_V(6); PG8_BAR;
    } else {
        PG8_STAGE(PG8_SB(0, 0), cB, voffB); PG8_STAGE(PG8_SA(0, 0), cA, voffA); PG8_STAGE(PG8_SB(0, 1), cB + hstep, voffB); PG8_STAGE(PG8_SA(0, 1), cA + hstep, voffA);
        if (wr == 1) PG8_BAR;
        PG8_WAIT_V(4); PG8_BAR;
        PG8_STAGE(PG8_SB(1, 0), cB + kstep, voffB); PG8_STAGE(PG8_SA(1, 0), cA + kstep, voffA); PG8_STAGE(PG8_SB(1, 1), cB + hstep + kstep, voffB);
        PG8_WAIT_V(6); PG8_BAR;
    }
    for (;;) {
        const bool has_next = S.next(ui + 1, nxt);
        const char* nA = has_next ? (const char*)g.A + (size_t)nxt.pm * tstep + nxt.ko : cA; const char* nB = has_next ? (const char*)g.Bt + (size_t)nxt.pn * tstep + nxt.ko : cB;
        for (int t = 0; t < nt; t += 2) {
            const bool last = (t == nt - 2);
            const char* a1 = cA + (size_t)(t + 1) * kstep;
            const char* a2 = last ? nA : cA + (size_t)(t + 2) * kstep; const char* b2 = last ? nB : cB + (size_t)(t + 2) * kstep;
            const char* a3 = a2 + kstep; const char* b3 = b2 + kstep;
            if (last && has_next) S.a_ready(nxt);
            if constexpr (SP2) {
            PG8_LDB(B0, 0, 0); PG8_LDB(B1, 0, 1); PG8_SCHED; PG8_LDA(At, 0, 0); PG8_STAGE(PG8_SA(1, 1), a1 + hstep, voffA);
            PG8_WAIT_V(8); PG8_WAIT_L(0); PG8_BAR; PG8_MMA(0, 0, At, B0); PG8_MMA(0, 1, At, B1); PG8_BAR; PG8_SCHED;
            PG8_LDA(At, 0, 1); PG8_STAGE(PG8_SB(0, 0), b2, voffB); PG8_STAGE(PG8_SB(0, 1), b2 + hstep, voffB); PG8_STAGE(PG8_SA(0, 0), a2, voffA);
            PG8_WAIT_V(8); PG8_WAIT_L(0); PG8_BAR; PG8_MMA(1, 0, At, B0); PG8_MMA(1, 1, At, B1); PG8_BAR; PG8_SCHED;
            PG8_LDB(B0, 1, 0); PG8_LDB(B1, 1, 1); PG8_SCHED; PG8_LDA(At, 1, 0); PG8_STAGE(PG8_SA(0, 1), a2 + hstep, voffA);
            PG8_WAIT_V(8); PG8_WAIT_L(0); PG8_BAR; PG8_MMA(0, 0, At, B0); PG8_MMA(0, 1, At, B1); PG8_BAR; PG8_SCHED;
            PG8_LDA(At, 1, 1); PG8_STAGE(PG8_SB(1, 0), b3, voffB); PG8_STAGE(PG8_SB(1, 1), b3 + hstep, voffB); PG8_STAGE(PG8_SA(1, 0), a3, voffA);
            PG8_WAIT_V(8); PG8_WAIT_L(0); PG8_BAR; PG8_MMA(1, 0, At, B0); PG8_MMA(1, 1, At, B1); PG8_BAR; PG8_SCHED;
            } else {
            PG8_LDB(B0, 0, 0); PG8_SCHED; PG8_LDA(At, 0, 0); PG8_STAGE(PG8_SA(1, 1), a1 + hstep, voffA);
            PG8_WAIT_L(8); PG8_BAR; PG8_WAIT_L(0); PG8_MMA(0, 0, At, B0); PG8_BAR; PG8_SCHED;
            PG8_LDB(B1, 0, 1); PG8_STAGE(PG8_SB(0, 0), b2, voffB);
            PG8_BAR; PG8_WAIT_L(0); PG8_MMA(0, 1, At, B1); PG8_BAR;
            PG8_LDA(At, 0, 1); PG8_STAGE(PG8_SA(0, 0), a2, voffA);
            PG8_BAR; PG8_WAIT_L(0); PG8_MMA(1, 0, At, B0); PG8_BAR; PG8_SCHED;
            PG8_STAGE(PG8_SB(0, 1), b2 + hstep, voffB);
            PG8_WAIT_V(6); PG8_BAR; PG8_MMA(1, 1, At, B1); PG8_BAR;
            PG8_LDB(B0, 1, 0); PG8_SCHED; PG8_LDA(At, 1, 0); PG8_STAGE(PG8_SA(0, 1), a2 + hstep, voffA);
            PG8_WAIT_L(8); PG8_BAR; PG8_WAIT_L(0); PG8_MMA(0, 0, At, B0); PG8_BAR; PG8_SCHED;
            PG8_LDB(B1, 1, 1); PG8_STAGE(PG8_SB(1, 0), b3, voffB);
            PG8_BAR; PG8_WAIT_L(0); PG8_MMA(0, 1, At, B1); PG8_BAR;
            PG8_LDA(At, 1, 1); PG8_STAGE(PG8_SA(1, 0), a3, voffA);
            PG8_BAR; PG8_WAIT_L(0); PG8_MMA(1, 0, At, B0); PG8_BAR; PG8_SCHED;
            PG8_STAGE(PG8_SB(1, 1), b3 + hstep, voffB);
            PG8_WAIT_V(6); PG8_BAR; PG8_MMA(1, 1, At, B1); PG8_BAR;
            }
        }
        if constexpr (ALIGN_EPI) { if (wr == 0) PG8_BAR; }
        if constexpr (!Epi::AFTER_DRAIN) { const int le_ = PG8_FRESH ? lane_fresh() : lane; E(acc, cur, wr, wc, le_ & 15, le_ >> 4);
            if constexpr (Epi::TWICE) { asm volatile("" ::: "memory"); E(acc, cur, wr, wc, le_ & 15, le_ >> 4); } S.done(cur); }
        if (!has_next) break;
#pragma unroll
        for (int a = 0; a < 2; ++a)
#pragma unroll
            for (int b = 0; b < 2; ++b)
#pragma unroll
                for (int m = 0; m < 4; ++m)
#pragma unroll
                    for (int n = 0; n < 2; ++n) acc[a][b][m][n] = (f32x4){0.f, 0.f, 0.f, 0.f};
        cur = nxt; cA = nA; cB = nB; ++ui;
        if constexpr (ALIGN_EPI) { if (wr == 1) PG8_BAR; }
    }
    PG8_WAIT_V(0);
    if constexpr (!ALIGN_EPI) { if (wr == 0) PG8_BAR; }
    PG8_BAR;
    if constexpr (Epi::AFTER_DRAIN) { E.fused(acc, cur, wr, wc, fr, fq, lds, wid, lane); S.done(cur); }
#undef PG8_SA
#undef PG8_SB
#undef PG8_STAGE
#undef PG8_LDA
#undef PG8_LDB
#undef PG8_MMA
#undef PG8_WAIT_V
#undef PG8_WAIT_L
#undef PG8_BAR
#undef PG8_SCHED
}
}

constexpr int DM = 4096, NB = 4, SEQ = 2048, CTX = 256, GW = 64, NH = 32, HD = 128, DFF = 8192, NMOD = 9;
constexpr int MX = NB * SEQ, MZ = NB * CTX, MALL = MX + MZ;
constexpr int MODW = NMOD * DM;
constexpr float EPS = 1e-6f, LOG2E = 1.4426950408889634f;
constexpr int KSPLIT = 8;

constexpr size_t MiB = 1u << 20;
constexpr size_t WS_CTL = 0, CTL_ZERO_BYTES = 1 * MiB;
constexpr size_t WS_MOD  = 2 * MiB;
constexpr size_t WS_SSP  = 4 * MiB;
constexpr size_t WS_NG   = 28 * MiB;
constexpr size_t WS_SSQ  = 29 * MiB;
constexpr size_t WS_PART = 8 * MiB;
constexpr size_t WS_WIN  = 32 * MiB;
constexpr size_t WS_WOUT = WS_WIN + 4 * 128 * MiB;
constexpr size_t WS_WQKV = WS_WOUT + 4 * 64 * MiB;
constexpr size_t WS_WO   = WS_WQKV + 96 * MiB;
constexpr size_t WS_SGIN = WS_WO + 32 * MiB;
constexpr size_t WS_SGOUT = WS_SGIN + 64 * MiB;
constexpr size_t WS_H    = WS_SGOUT + 32 * MiB;
constexpr size_t WS_ACT  = WS_H + 72 * MiB;
constexpr size_t WS_QKV  = WS_ACT + 144 * MiB;
constexpr size_t WS_AO   = WS_QKV + 216 * MiB;
constexpr size_t WS_XS   = WS_AO + 72 * MiB;
constexpr size_t WS_U    = WS_XS + 144 * MiB;
constexpr size_t WS_V    = WS_U + 64 * MiB;
constexpr size_t WS_T    = WS_V + 64 * MiB;
constexpr size_t WS_XB   = WS_T + 64 * MiB;
constexpr size_t WS_PARTZ = WS_XB + 72 * MiB;
constexpr size_t WS_SWP  = WS_PARTZ + 64 * MiB;
constexpr size_t WS_SW   = WS_SWP + 96 * MiB;
constexpr size_t WS_END  = WS_SW + 2 * MiB;
constexpr int CW_BAR = 4096;

constexpr int RING_BYTES = 135168;
constexpr int MISC_OFF = RING_BYTES;
constexpr int LDS_BYTES = 139264;
constexpr int NWAVES = 8;

#define GAS __attribute__((address_space(1)))
#define LAS __attribute__((address_space(3)))
typedef unsigned short bf16;
typedef unsigned v4u __attribute__((ext_vector_type(4)));
typedef unsigned v2u __attribute__((ext_vector_type(2)));
typedef float f32x4 __attribute__((ext_vector_type(4)));
typedef float f32x16 __attribute__((ext_vector_type(16)));
typedef short bf16x8 __attribute__((ext_vector_type(8)));
typedef short s16x4 __attribute__((ext_vector_type(4)));
#define LDS_WAIT() asm volatile("s_waitcnt lgkmcnt(0)" ::: "memory")
#define VM_WAIT() asm volatile("s_waitcnt vmcnt(0)" ::: "memory")
#define SBAR() __builtin_amdgcn_sched_barrier(0)
__device__ __forceinline__ unsigned cvtpk(float lo, float hi) { unsigned r; asm volatile("v_cvt_pk_bf16_f32 %0, %1, %2" : "=v"(r) : "v"(lo), "v"(hi)); return r; }
__device__ __forceinline__ float bf_lo(unsigned w) { return __builtin_bit_cast(float, w << 16); }
__device__ __forceinline__ float bf_hi(unsigned w) { return __builtin_bit_cast(float, w & 0xffff0000u); }
__device__ __forceinline__ float wave_sum(float v) {
#pragma unroll
    for (int o = 1; o < 64; o <<= 1) v += __shfl_xor(v, o);
    return v;
}
__device__ __forceinline__ int lane_now() { int l; asm volatile("v_mbcnt_lo_u32_b32 %0, -1, 0\n\tv_mbcnt_hi_u32_b32 %0, -1, %0" : "=v"(l)); return l; }
#define XB_TMO      128
#define XB_XCNT(j)  (256  + 64 * (j))
#define XB_XSUB(j)  (1280 + 64 * (j))
#define XB_XGEN(j)  (2304 + 64 * (j))
#define XB_TOP      3328
#define XB_TOPGEN   3392
#define XCD_BAR_WORDS 3456
#define XB_SPIN_CAP (1u << 18)

__device__ __forceinline__ unsigned xb_ld(unsigned* p)              { return __hip_atomic_load(p, __ATOMIC_RELAXED, __HIP_MEMORY_SCOPE_AGENT); }
__device__ __forceinline__ unsigned xb_add(unsigned* p, unsigned v) { return __hip_atomic_fetch_add(p, v, __ATOMIC_RELAXED, __HIP_MEMORY_SCOPE_AGENT); }
__device__ __forceinline__ unsigned xb_xcc_id() { return (unsigned)__builtin_amdgcn_s_getreg((3 << 11) | 20) & 0xFu; }
#define XB_SPIN(cond, bar) do { unsigned _sp = 0; while (cond) { __builtin_amdgcn_s_sleep(1); \
    if ((++_sp & 255u) == 0u) { if (xb_ld(&(bar)[XB_TMO])) break; if (_sp > XB_SPIN_CAP) { atomicAdd(&(bar)[XB_TMO], 1u); break; } } } } while (0)

struct XcdBarrier {
    unsigned* bar; unsigned x;
    volatile LAS unsigned* st;
};

__device__ __forceinline__ XcdBarrier xcd_barrier_post(unsigned* bar, volatile LAS unsigned* st) {
    XcdBarrier b; b.bar = bar; b.x = xb_xcc_id(); b.st = st;
    if (threadIdx.x == 0) (void)xb_add(&bar[XB_XCNT(b.x)], 1u);
    return b;
}
__device__ __forceinline__ void xcd_barrier_complete(unsigned* bar, unsigned x, unsigned& nloc, unsigned& nx) {
    const unsigned G = gridDim.x * gridDim.y * gridDim.z;
    unsigned sum, cnt, mine, sp = 0u;
    for (;;) {
        sum = 0u; cnt = 0u; mine = 0u;
#pragma unroll
        for (unsigned j = 0; j < 16; ++j) { const unsigned c = xb_ld(&bar[XB_XCNT(j)]); sum += c; cnt += (c > 0u) ? 1u : 0u; mine = (j == x) ? c : mine; }
        if (sum == G) break;
        __builtin_amdgcn_s_sleep(1);
        if ((++sp & 255u) == 0u) { if (xb_ld(&bar[XB_TMO])) break; if (sp > XB_SPIN_CAP) { atomicAdd(&bar[XB_TMO], 1u); break; } }
    }
    nloc = mine > 0u ? mine : 1u; nx = cnt > 0u ? cnt : 1u;
}

__device__ __forceinline__ void xcd_barrier(const XcdBarrier& b) {
    asm volatile("s_waitcnt vmcnt(0)" ::: "memory");
    __syncthreads();
    if (threadIdx.x == 0) {
        unsigned* bar = b.bar;
        __builtin_amdgcn_s_waitcnt(0);
        unsigned nloc = b.st[0], nx = b.st[1];
        if (nloc == 0u) { xcd_barrier_complete(bar, b.x, nloc, nx); b.st[0] = nloc; b.st[1] = nx; }
        const unsigned old = xb_add(&bar[XB_XSUB(b.x)], 1u);
        const unsigned gen = old / nloc;
        if (old + 1u == (gen + 1u) * nloc) {
            __builtin_amdgcn_fence(__ATOMIC_RELEASE, "agent");
            asm volatile("s_waitcnt vmcnt(0)" ::: "memory");
            const unsigned og = xb_add(&bar[XB_TOP], 1u);
            const unsigned tg = og / nx;
            if (og + 1u == (tg + 1u) * nx) xb_add(&bar[XB_TOPGEN], 1u);
            else XB_SPIN(xb_ld(&bar[XB_TOPGEN]) == tg, bar);
            __builtin_amdgcn_fence(__ATOMIC_ACQUIRE, "agent");
            xb_add(&bar[XB_XGEN(b.x)], 1u);
            asm volatile("s_waitcnt vmcnt(0)" ::: "memory");
        } else {
            XB_SPIN(xb_ld(&bar[XB_XGEN(b.x)]) == gen, bar);
            __builtin_amdgcn_fence(__ATOMIC_ACQUIRE, "agent");
            asm volatile("s_waitcnt vmcnt(0)" ::: "memory");
        }
    }
    __syncthreads();
}

#ifndef ADA_WAVES
#define ADA_WAVES 8
#endif
__device__ __forceinline__ void p_ada_partial(const float* c, const float* cctx, const float* wada, float* part, LAS unsigned char* lds, int vcu, int G, int tid, int wave, int lane) {
    constexpr int KW = DM / KSPLIT / ADA_WAVES;
    LAS float* sil = (LAS float*)(lds + 65536) + wave * (5 * KW);
    LAS float* red = (LAS float*)lds;
    constexpr int NITEM = 2 * (MODW / 256) * KSPLIT;
    for (int it = vcu; it < NITEM; it += G) {
        const int i = it / ((MODW / 256) * KSPLIT), rem = it % ((MODW / 256) * KSPLIT), cg = rem / KSPLIT, ks = rem % KSPLIT;
        const int k0 = ks * (DM / KSPLIT) + wave * KW;
        if (wave < ADA_WAVES) {
        const GAS float* wp = (const GAS float*)wada + ((size_t)i * DM + k0) * MODW + cg * 256 + 4 * lane;
        f32x4 wA[16], wB[16];
#pragma unroll
        for (int j = 0; j < 16; ++j) wA[j] = __builtin_nontemporal_load((const GAS f32x4*)(wp + (size_t)j * MODW));
#pragma unroll
        for (int j = 0; j < 5 * KW / 64; ++j) { const int idx = lane + 64 * j; const int r = idx / KW, kk = idx % KW;
            const float x = (r < 4) ? ((const GAS float*)c)[r * DM + k0 + kk] : ((const GAS float*)cctx)[k0 + kk];
            sil[idx] = x * __builtin_amdgcn_rcpf(1.0f + __builtin_amdgcn_exp2f(-x * LOG2E)); }
        f32x4 acc[5];
#pragma unroll
        for (int r = 0; r < 5; ++r) acc[r] = (f32x4){0.f, 0.f, 0.f, 0.f};
        LDS_WAIT();
#pragma unroll
        for (int hb = 0; hb < KW / 16; hb += 2) {
#pragma unroll
            for (int j = 0; j < 16; ++j) wB[j] = __builtin_nontemporal_load((const GAS f32x4*)(wp + (size_t)((hb + 1) * 16 + j) * MODW));
#pragma unroll
            for (int j = 0; j < 16; ++j)
#pragma unroll
                for (int r = 0; r < 5; ++r) acc[r] += wA[j] * sil[r * KW + hb * 16 + j];
            if (hb + 2 < KW / 16) {
#pragma unroll
                for (int j = 0; j < 16; ++j) wA[j] = __builtin_nontemporal_load((const GAS f32x4*)(wp + (size_t)((hb + 2) * 16 + j) * MODW)); }
#pragma unroll
            for (int j = 0; j < 16; ++j)
#pragma unroll
                for (int r = 0; r < 5; ++r) acc[r] += wB[j] * sil[r * KW + (hb + 1) * 16 + j];
        }
#pragma unroll
        for (int r = 0; r < 5; ++r) *(LAS f32x4*)(red + (wave * 5 + r) * 256 + 4 * lane) = acc[r];
        }
        __syncthreads();
        if (tid < 320) { const int r = tid >> 6, c4 = tid & 63; f32x4 s = (f32x4){0.f, 0.f, 0.f, 0.f};
#pragma unroll
            for (int w = 0; w < ADA_WAVES; ++w) s += *(LAS f32x4*)(red + (w * 5 + r) * 256 + 4 * c4);
            *(GAS f32x4*)((GAS float*)part + ((size_t)(ks * 5 + r) * 2 + i) * MODW + cg * 256 + 4 * c4) = s; }
        __syncthreads();
    }
}
__device__ __forceinline__ void p_mod_finalize(const float* part, const float* bada, float* mod, int gw, int NGW, int lane) {
    constexpr int N4 = 2 * 5 * MODW / 4;
    for (int idx = gw * 64 + lane; idx < N4; idx += NGW * 64) {
        const int e = idx * 4, i = e / (5 * MODW), r = (e / MODW) % 5, col = e % MODW;
        f32x4 s = *(const GAS f32x4*)((const GAS float*)bada + (size_t)i * MODW + col);
#pragma unroll
        for (int ks = 0; ks < KSPLIT; ++ks) s += *(const GAS f32x4*)((const GAS float*)part + ((size_t)(ks * 5 + r) * 2 + i) * MODW + col);
        *(GAS f32x4*)((GAS float*)mod + (size_t)(i * 5 + r) * MODW + col) = s;
    }
}
__device__ __forceinline__ void p_copy_normg(const float* normg, float* ng, int gw, int NGW, int lane) {
    for (int idx = gw * 64 + lane; idx < 6 * DM / 4; idx += NGW * 64) ((GAS f32x4*)ng)[idx] = ((const GAS f32x4*)normg)[idx];
}
#ifndef CVT_NTSTORE
#define CVT_NTSTORE 0
#endif
#ifndef CVT_KFAST
#define CVT_KFAST 0
#endif
__device__ __forceinline__ unsigned f2bf(float f) { unsigned u = __builtin_bit_cast(unsigned, f); return (u + 0x7fffu + ((u >> 16) & 1u)) >> 16; }
__device__ __forceinline__ unsigned pk2(float lo, float hi) { return f2bf(lo) | (f2bf(hi) << 16); }
__device__ __forceinline__ void cvt_item(const float* W, int K, int N, bf16* WT, bool swiglu, LAS float* scr, int item, int lane, const float* shiftv, float* swp) {
    #if CVT_KFAST
    const int kblk = K >> 6, nb = item / kblk, kb = item - nb * kblk, k0 = kb << 6, n0 = nb << 6;
#else
    const int nblk = N >> 6, kb = item / nblk, nb = item - kb * nblk, k0 = kb << 6, n0 = nb << 6;
#endif
    const int c4 = lane & 15, rr = lane >> 4;
    const GAS float* src = (const GAS float*)W + (size_t)(k0 + rr) * N + n0 + 4 * c4;
    f32x4 v[16];
#pragma unroll
    for (int j = 0; j < 16; ++j) v[j] = __builtin_nontemporal_load((const GAS f32x4*)(src + (size_t)(4 * j) * N));
#pragma unroll
    for (int j = 0; j < 16; ++j) { LAS float* d = scr + (4 * j + rr) * 65 + 4 * c4; d[0] = v[j].x; d[1] = v[j].y; d[2] = v[j].z; d[3] = v[j].w; }
    int vrow0 = n0;
    if (swiglu) { const int half = N >> 1; vrow0 = (n0 < half) ? (((n0 >> 7) << 8) + (n0 & 127)) : ((((n0 - half) >> 7) << 8) + 128 + ((n0 - half) & 127)); }
    if (shiftv) { LAS float* shl = scr + 64 * 65;
#pragma unroll
        for (int b = 0; b < 5; ++b) shl[b * 64 + lane] = ((const GAS float*)shiftv)[(size_t)b * MODW + k0 + lane];
        LDS_WAIT(); asm volatile("" ::: "memory");
        f32x4 sa[5];
#pragma unroll
        for (int b = 0; b < 5; ++b) { sa[b] = (f32x4){0.f, 0.f, 0.f, 0.f};
#pragma unroll
            for (int j = 0; j < 16; ++j) sa[b] += v[j] * shl[b * 64 + 4 * j + rr]; }
#pragma unroll
        for (int b = 0; b < 5; ++b) {
#pragma unroll
            for (int e = 0; e < 4; ++e) { float t = sa[b][e]; t += __shfl_xor(t, 16); t += __shfl_xor(t, 32); sa[b][e] = t; }
            if (rr == 0) *(GAS f32x4*)((GAS float*)swp + ((size_t)kb * 5 + b) * N + vrow0 + 4 * c4) = sa[b]; } }
    LDS_WAIT(); asm volatile("" ::: "memory");
    const int c8 = lane & 7;
#pragma unroll
    for (int j2 = 0; j2 < 8; ++j2) { const int n = (lane >> 3) + 8 * j2; const LAS float* s = scr + (8 * c8) * 65 + n;
        v4u o; o.x = cvtpk(s[0 * 65], s[1 * 65]); o.y = cvtpk(s[2 * 65], s[3 * 65]); o.z = cvtpk(s[4 * 65], s[5 * 65]); o.w = cvtpk(s[6 * 65], s[7 * 65]);
#if CVT_NTSTORE
        __builtin_nontemporal_store(o, (GAS v4u*)((GAS bf16*)WT + (size_t)(vrow0 + n) * K + k0 + 8 * c8)); }
#else
        *(GAS v4u*)((GAS bf16*)WT + (size_t)(vrow0 + n) * K + k0 + 8 * c8) = o; }
#endif
    LDS_WAIT(); asm volatile("" ::: "memory");
}
__device__ __forceinline__ constexpr int cvt_items_of(int mat) { return mat < 4 ? (DM / 64) * (2 * DFF / 64) : mat < 8 ? (DFF / 64) * (DM / 64) : mat == 8 ? (DM / 64) * (3 * DM / 64) : mat == 10 ? (DM / 64) * (2 * DM / 64) : (DM / 64) * (DM / 64); }
__device__ __forceinline__ void p_modulate(const float* xs_x, const float* xs_z, const float* gain, const float* modl, int j, bf16* H, int M, int gw, int NGW, int lane) {
    for (int m = gw; m < M; m += NGW) {
        const bool isx = m < MX; const int bidx = isx ? (m >> 11) : 4;
        const GAS f32x4* xr = (const GAS f32x4*)((isx ? (const GAS float*)xs_x + (size_t)m * DM : (const GAS float*)xs_z + (size_t)(m - MX) * DM)) + lane;
        const GAS f32x4* gp = (const GAS f32x4*)((const GAS float*)gain) + lane;
        const GAS f32x4* shp = (const GAS f32x4*)((const GAS float*)modl + (size_t)bidx * MODW + (3 * j) * DM) + lane;
        const GAS f32x4* scp = (const GAS f32x4*)((const GAS float*)modl + (size_t)bidx * MODW + (3 * j + 1) * DM) + lane;
        f32x4 v[16]; float s = 0.f;
#pragma unroll
        for (int q = 0; q < 16; ++q) { v[q] = xr[64 * q]; s += (v[q].x * v[q].x + v[q].y * v[q].y) + (v[q].z * v[q].z + v[q].w * v[q].w); }
        const float rstd = 1.0f / sqrtf(wave_sum(s) * (1.0f / DM) + EPS);
        GAS v2u* o8 = (GAS v2u*)((GAS bf16*)H + (size_t)m * DM) + lane;
#pragma unroll
        for (int q = 0; q < 16; ++q) { const f32x4 g = gp[64 * q], sc = scp[64 * q], sh = shp[64 * q];
            const f32x4 y = v[q] * rstd * g * (sc + 1.0f) + sh; v2u o; o.x = cvtpk(y.x, y.y); o.y = cvtpk(y.z, y.w); o8[64 * q] = o; }
    }
}
__device__ __forceinline__ void p_modulate_b(const bf16* XB, const float* ssq, const float* gain, const float* modl, int j, bf16* H, int M, int gw, int NGW, int lane) {
    for (int m = gw; m < M; m += NGW) {
        const int bidx = (m < MX) ? (m >> 11) : 4;
        const GAS v4u* xr = (const GAS v4u*)((const GAS bf16*)XB + (size_t)m * DM) + lane;
        v4u v[8];
#pragma unroll
        for (int q = 0; q < 8; ++q) v[q] = xr[64 * q];
        const float rstd = 1.0f / sqrtf(wave_sum(((const GAS float*)ssq)[(size_t)m * 64 + lane]) * (1.0f / DM) + EPS);
        const GAS f32x4* gp = (const GAS f32x4*)((const GAS float*)gain) + 2 * lane;
        const GAS f32x4* shp = (const GAS f32x4*)((const GAS float*)modl + (size_t)bidx * MODW + (3 * j) * DM) + 2 * lane;
        const GAS f32x4* scp = (const GAS f32x4*)((const GAS float*)modl + (size_t)bidx * MODW + (3 * j + 1) * DM) + 2 * lane;
        GAS v4u* o16 = (GAS v4u*)((GAS bf16*)H + (size_t)m * DM) + lane;
#pragma unroll
        for (int q = 0; q < 8; ++q) { const f32x4 g0 = gp[128 * q], g1 = gp[128 * q + 1], c0 = scp[128 * q], c1 = scp[128 * q + 1], h0 = shp[128 * q], h1 = shp[128 * q + 1];
            const f32x4 x0 = (f32x4){bf_lo(v[q].x), bf_hi(v[q].x), bf_lo(v[q].y), bf_hi(v[q].y)}, x1 = (f32x4){bf_lo(v[q].z), bf_hi(v[q].z), bf_lo(v[q].w), bf_hi(v[q].w)};
            const f32x4 y0 = x0 * rstd * g0 * (c0 + 1.0f) + h0, y1 = x1 * rstd * g1 * (c1 + 1.0f) + h1;
            v4u o; o.x = cvtpk(y0.x, y0.y); o.y = cvtpk(y0.z, y0.w); o.z = cvtpk(y1.x, y1.y); o.w = cvtpk(y1.z, y1.w); o16[64 * q] = o; }
    }
}
__device__ __forceinline__ void p_modulate_l0(const float* xs_x, const float* ctx, const float* partz, const float* gain, const float* modl, int j, int gslot, bf16* H, int gw, int NGW, int lane) {
    const int nrows = (NGW == 2048) ? (gw < 1024 ? 4 : 5) : (MALL + NGW - 1) / NGW;
    for (int it = 0; it < nrows; ++it) {
        int m;
        if (NGW == 2048) m = (gw < 1024) ? (it == 0 ? MX + gw : gw * 3 + it - 1) : 3072 + (gw - 1024) * 5 + it;
        else { m = gw + it * NGW; if (m >= MALL) break; }
        const bool isx = m < MX; const int bidx = isx ? (m >> 11) : 4;
        const GAS f32x4* gp = (const GAS f32x4*)((const GAS float*)gain) + lane;
        const GAS f32x4* shp = (const GAS f32x4*)((const GAS float*)modl + (size_t)bidx * MODW + (3 * j) * DM) + lane;
        const GAS f32x4* scp = (const GAS f32x4*)((const GAS float*)modl + (size_t)bidx * MODW + (3 * j + 1) * DM) + lane;
        f32x4 v[16]; float s = 0.f;
        if (isx) { const GAS f32x4* xr = (const GAS f32x4*)((const GAS float*)xs_x + (size_t)m * DM) + lane;
#pragma unroll
            for (int q = 0; q < 16; ++q) v[q] = xr[64 * q]; }
        else { const size_t zo = (size_t)(m - MX) * DM; const GAS f32x4* cr = (const GAS f32x4*)((const GAS float*)ctx + zo) + lane;
            const GAS f32x4* gt = (const GAS f32x4*)((const GAS float*)modl + (size_t)4 * MODW + gslot * DM) + lane; const GAS f32x4* pz = (const GAS f32x4*)((const GAS float*)partz + zo) + lane;
#pragma unroll
            for (int q = 0; q < 16; ++q) { const f32x4 p = (pz[64 * q] + pz[64 * q + (size_t)MZ * DM / 4]) + (pz[64 * q + (size_t)2 * MZ * DM / 4] + pz[64 * q + (size_t)3 * MZ * DM / 4]);
                v[q] = cr[64 * q] + gt[64 * q] * 0.5f * p; } }
#pragma unroll
        for (int q = 0; q < 16; ++q) s += (v[q].x * v[q].x + v[q].y * v[q].y) + (v[q].z * v[q].z + v[q].w * v[q].w);
        const float rstd = 1.0f / sqrtf(wave_sum(s) * (1.0f / DM) + EPS);
        GAS v2u* o8 = (GAS v2u*)((GAS bf16*)H + (size_t)m * DM) + lane;
#pragma unroll
        for (int q = 0; q < 16; ++q) { const f32x4 g = gp[64 * q], sc = scp[64 * q], sh = shp[64 * q];
            const f32x4 y = v[q] * rstd * g * (sc + 1.0f) + sh; v2u o; o.x = cvtpk(y.x, y.y); o.y = cvtpk(y.z, y.w); o8[64 * q] = o; }
    }
}
__device__ __forceinline__ void p_sw_reduce(const float* swp, float* sw, int gw, int NGW, int lane) {
    for (int idx = gw * 64 + lane; idx < 5 * 5 * 4096; idx += NGW * 64) {
        const int m = idx / (5 * 4096), b = (idx / 4096) % 5, c4 = idx % 4096; const int N = (m == 0) ? 3 * DM : (m == 4) ? 2 * DM : 2 * DFF;
        if (4 * c4 >= N) continue;
        const size_t mbase = (m == 0) ? 0 : (size_t)64 * 5 * 3 * DM + (size_t)(m - 1) * 64 * 5 * 2 * DFF;
        const GAS f32x4* sp = (const GAS f32x4*)((const GAS float*)swp + mbase + (size_t)b * N) + c4; f32x4 a = (f32x4){0.f, 0.f, 0.f, 0.f};
#pragma unroll 8
        for (int kb = 0; kb < 64; ++kb) a += sp[(size_t)kb * 5 * N / 4];
        *(GAS f32x4*)((GAS float*)sw + ((size_t)m * 5 + b) * 16384 + 4 * c4) = a;
    }
}

#ifndef ATT_STAGGER
#define ATT_STAGGER 0
#endif
#ifndef ATT_PERM
#define ATT_PERM 0
#endif
#ifndef ATT_DPP
#define ATT_DPP 1
#endif
namespace att {
constexpr int SHM_K = 16384, SHM_V = 16384;
constexpr int OFF_V = 0, OFF_K = 3 * SHM_V, OFF_TAB = OFF_K + 2 * SHM_K, OFF_WS = OFF_TAB + 2048;
#define KSWZ(row, colB) ((row) * 256 + ((colB) ^ (((row) & 7) << 4)))
__device__ __forceinline__ int crow(int r, int hi) { return (r & 3) + 8 * (r >> 2) + 4 * hi; }
__device__ __forceinline__ int v_st(int k, int c) { const int kk = (k & ~0xC) | ((k & 4) << 1) | ((k & 8) >> 1); return ((kk >> 3) * 4 + (c >> 5)) * 512 + ((kk & 7) * 32 + (c & 31)) * 2; }
__device__ __forceinline__ int v_rd_base(int lane) { return ((lane & 3) << 3) | (((lane >> 2) & 3) << 6) | (((lane >> 4) & 1) << 5) | (((lane >> 5) & 1) << 8); }
constexpr int v_rd_off(int d0, int ks, int half) { return d0 * 512 + ks * 4096 + half * 2048; }
template <int OFF> __device__ __forceinline__ s16x4 tr_read(int vb) {
    s16x4 r; asm volatile("ds_read_b64_tr_b16 %0, %1 offset:%2" : "=&v"(r) : "v"(vb), "i"(OFF) : "memory"); return r;
}
template <int D0> __device__ __forceinline__ void pv_one(f32x16& od, int vb, bf16x8 pa0, bf16x8 pa1, bf16x8 pa2, bf16x8 pa3) {
    const s16x4 l0 = tr_read<v_rd_off(D0, 0, 0)>(vb), h0 = tr_read<v_rd_off(D0, 0, 1)>(vb), l1 = tr_read<v_rd_off(D0, 1, 0)>(vb), h1 = tr_read<v_rd_off(D0, 1, 1)>(vb);
    const s16x4 l2 = tr_read<v_rd_off(D0, 2, 0)>(vb), h2 = tr_read<v_rd_off(D0, 2, 1)>(vb), l3 = tr_read<v_rd_off(D0, 3, 0)>(vb), h3 = tr_read<v_rd_off(D0, 3, 1)>(vb);
    asm volatile("s_waitcnt lgkmcnt(0)" ::: "memory"); SBAR();
#define PKLH(L, H) (bf16x8){L[0], L[1], L[2], L[3], H[0], H[1], H[2], H[3]}
    od = __builtin_amdgcn_mfma_f32_32x32x16_bf16(pa0, PKLH(l0, h0), od, 0, 0, 0);
    od = __builtin_amdgcn_mfma_f32_32x32x16_bf16(pa1, PKLH(l1, h1), od, 0, 0, 0);
    od = __builtin_amdgcn_mfma_f32_32x32x16_bf16(pa2, PKLH(l2, h2), od, 0, 0, 0);
    od = __builtin_amdgcn_mfma_f32_32x32x16_bf16(pa3, PKLH(l3, h3), od, 0, 0, 0);
}
template <int D0> __device__ __forceinline__ void vt_one(f32x16& od, int vb, bf16x8 pa0, bf16x8 pa1, bf16x8 pa2, bf16x8 pa3) {
    const s16x4 l0 = tr_read<v_rd_off(D0, 0, 0)>(vb), h0 = tr_read<v_rd_off(D0, 0, 1)>(vb), l1 = tr_read<v_rd_off(D0, 1, 0)>(vb), h1 = tr_read<v_rd_off(D0, 1, 1)>(vb);
    const s16x4 l2 = tr_read<v_rd_off(D0, 2, 0)>(vb), h2 = tr_read<v_rd_off(D0, 2, 1)>(vb), l3 = tr_read<v_rd_off(D0, 3, 0)>(vb), h3 = tr_read<v_rd_off(D0, 3, 1)>(vb);
    asm volatile("s_waitcnt lgkmcnt(0)" ::: "memory"); SBAR();
    od = __builtin_amdgcn_mfma_f32_32x32x16_bf16(PKLH(l0, h0), pa0, od, 0, 0, 0);
    od = __builtin_amdgcn_mfma_f32_32x32x16_bf16(PKLH(l1, h1), pa1, od, 0, 0, 0);
    od = __builtin_amdgcn_mfma_f32_32x32x16_bf16(PKLH(l2, h2), pa2, od, 0, 0, 0);
    od = __builtin_amdgcn_mfma_f32_32x32x16_bf16(PKLH(l3, h3), pa3, od, 0, 0, 0);
}
__device__ __forceinline__ void qkt_acc(f32x16& p0, f32x16& p1, const LAS unsigned char* Ks, const bf16x8* qr, int r32, int hi) {
#pragma unroll
    for (int d0 = 0; d0 < 8; ++d0) { const int cb = (d0 * 16 + hi * 8) * 2;
        const bf16x8 b0 = *(const LAS bf16x8*)(Ks + KSWZ(r32, cb));
        const bf16x8 b1 = *(const LAS bf16x8*)(Ks + KSWZ(32 + r32, cb));
        p0 = __builtin_amdgcn_mfma_f32_32x32x16_bf16(b0, qr[d0], p0, 0, 0, 0);
        p1 = __builtin_amdgcn_mfma_f32_32x32x16_bf16(b1, qr[d0], p1, 0, 0, 0); }
}
__device__ __forceinline__ bf16x8 knorm8(v4u raw, const float (&kg)[8]) {
    float x[8]; x[0] = bf_lo(raw.x); x[1] = bf_hi(raw.x); x[2] = bf_lo(raw.y); x[3] = bf_hi(raw.y); x[4] = bf_lo(raw.z); x[5] = bf_hi(raw.z); x[6] = bf_lo(raw.w); x[7] = bf_hi(raw.w);
    float ss = 0.f;
#pragma unroll
    for (int j = 0; j < 8; ++j) ss += x[j] * x[j];
#if ATT_DPP
    ss += __builtin_bit_cast(float, __builtin_amdgcn_update_dpp(0, __builtin_bit_cast(int, ss), 0xB1, 0xF, 0xF, true));
    ss += __builtin_bit_cast(float, __builtin_amdgcn_update_dpp(0, __builtin_bit_cast(int, ss), 0x4E, 0xF, 0xF, true));
    ss += __builtin_bit_cast(float, __builtin_amdgcn_update_dpp(0, __builtin_bit_cast(int, ss), 0x141, 0xF, 0xF, true));
    ss += __builtin_bit_cast(float, __builtin_amdgcn_update_dpp(0, __builtin_bit_cast(int, ss), 0x140, 0xF, 0xF, true));
#else
    ss += __shfl_xor(ss, 1); ss += __shfl_xor(ss, 2); ss += __shfl_xor(ss, 4); ss += __shfl_xor(ss, 8);
#endif
    const float rstd = 1.0f / sqrtf(ss * (1.0f / HD) + EPS);
    v4u w; w.x = cvtpk(x[0] * rstd * kg[0], x[1] * rstd * kg[1]); w.y = cvtpk(x[2] * rstd * kg[2], x[3] * rstd * kg[3]);
    w.z = cvtpk(x[4] * rstd * kg[4], x[5] * rstd * kg[5]); w.w = cvtpk(x[6] * rstd * kg[6], x[7] * rstd * kg[7]);
    return __builtin_bit_cast(bf16x8, w);
}
__device__ __forceinline__ void attn_unit(bool lat, int b, int h, int rg, const bf16* QKV, bf16* AO, const float* qgain, const float* kgain, const float* rpb, LAS unsigned char* lds, int tid, int wid, int lane) {
    const int r32 = lane & 31, hi = lane >> 5;
    LAS unsigned char* V_lds = lds + OFF_V; LAS unsigned char* K_lds = lds + OFF_K; LAS float* TAB = (LAS float*)(lds + OFF_TAB);
    LAS float* wsl = (LAS float*)(lds + OFF_WS) + wid * 64; LAS float* li_l = wsl; LAS float* al_l = wsl + 32;
    constexpr int LDQ = 3 * DM;
    const int rq = 4 * rg + (wid >> 1);
    const int klo = lat ? min(max(4 * rg - 4, 0), 24) : 0, khi = lat ? min(max(4 * rg - 1, 0), 24) + 7 : -1, nlat = khi - klo + 1, ntile = nlat + 4;
    const int r0q = min(max(rq - 4, 0), 24);
    const int qrow0 = lat ? b * SEQ + 64 * rq + 32 * (wid & 1) : MX + b * CTX + 32 * wid;
    const int cq = 32 * (wid & 1) + r32, cs = min(max(cq - 8, 0), 48);
    if (lat && tid < 480) { const int i = tid & 31; TAB[tid] = (i < 31) ? ((const GAS float*)rpb)[h * 465 + (tid >> 5) * 31 + i] * LOG2E : -1e30f; }
    bf16x8 qr[8];
    { const GAS bf16* Qp = (const GAS bf16*)QKV + (size_t)(qrow0 + r32) * LDQ + h * HD + hi * 8;
      v4u raw[8]; float ss = 0.f;
#pragma unroll
      for (int d0 = 0; d0 < 8; ++d0) { raw[d0] = *(const GAS v4u*)(Qp + d0 * 16);
          const float a0 = bf_lo(raw[d0].x), a1 = bf_hi(raw[d0].x), a2 = bf_lo(raw[d0].y), a3 = bf_hi(raw[d0].y), a4 = bf_lo(raw[d0].z), a5 = bf_hi(raw[d0].z), a6 = bf_lo(raw[d0].w), a7 = bf_hi(raw[d0].w);
          ss += (a0 * a0 + a1 * a1) + (a2 * a2 + a3 * a3) + (a4 * a4 + a5 * a5) + (a6 * a6 + a7 * a7); }
      ss += __shfl_xor(ss, 32);
      const float sc = (1.0f / sqrtf(ss * (1.0f / HD) + EPS)) * (0.08838834764831845f * LOG2E);
#pragma unroll
      for (int d0 = 0; d0 < 8; ++d0) { const GAS f32x4* gq = (const GAS f32x4*)((const GAS float*)qgain + d0 * 16 + hi * 8); const f32x4 g0 = gq[0], g1 = gq[1];
          v4u w; w.x = cvtpk(bf_lo(raw[d0].x) * sc * g0.x, bf_hi(raw[d0].x) * sc * g0.y); w.y = cvtpk(bf_lo(raw[d0].y) * sc * g0.z, bf_hi(raw[d0].y) * sc * g0.w);
          w.z = cvtpk(bf_lo(raw[d0].z) * sc * g1.x, bf_hi(raw[d0].z) * sc * g1.y); w.w = cvtpk(bf_lo(raw[d0].w) * sc * g1.z, bf_hi(raw[d0].w) * sc * g1.w);
          qr[d0] = __builtin_bit_cast(bf16x8, w); } }
    const int sr = tid >> 4, sc8 = (tid & 15) * 8, vst0 = v_st(sr, sc8), vst1 = v_st(32 + sr, sc8), kst0 = KSWZ(sr, sc8 * 2), kst1 = KSWZ(32 + sr, sc8 * 2);
    float kg[8];
    { const GAS f32x4* gk = (const GAS f32x4*)((const GAS float*)kgain + sc8); const f32x4 g0 = gk[0], g1 = gk[1]; kg[0] = g0.x; kg[1] = g0.y; kg[2] = g0.z; kg[3] = g0.w; kg[4] = g1.x; kg[5] = g1.y; kg[6] = g1.z; kg[7] = g1.w; }
    const int vb0 = (int)(uintptr_t)V_lds + v_rd_base(lane);
    v4u ks0, ks1, vs0, vs1;
#define ATT_KROW(jt) ((jt) < nlat ? b * SEQ + 64 * (klo + (jt)) : MX + b * CTX + 64 * ((jt) - nlat))
#define ATT_SLOAD(jt) do { const GAS bf16* kp = (const GAS bf16*)QKV + (size_t)(ATT_KROW(jt) + sr) * LDQ + DM + h * HD + sc8; \
        ks0 = *(const GAS v4u*)kp; ks1 = *(const GAS v4u*)(kp + (size_t)32 * LDQ); vs0 = *(const GAS v4u*)(kp + DM); vs1 = *(const GAS v4u*)(kp + (size_t)32 * LDQ + DM); } while (0)
#define ATT_SWRITE(kbufi, vbufi) do { *(LAS v4u*)(V_lds + (vbufi) * SHM_V + vst0) = vs0; *(LAS v4u*)(V_lds + (vbufi) * SHM_V + vst1) = vs1; \
        *(LAS bf16x8*)(K_lds + (kbufi) * SHM_K + kst0) = knorm8(ks0, kg); *(LAS bf16x8*)(K_lds + (kbufi) * SHM_K + kst1) = knorm8(ks1, kg); } while (0)
    unsigned bo0[4] = {0u, 0u, 0u, 0u}, bo1[4] = {0u, 0u, 0u, 0u};
#pragma unroll
    for (int r = 0; r < 16; ++r) { const int ck0 = crow(r, hi), ck1 = 32 + ck0;
        bo0[r >> 2] |= (unsigned)(4 * (((unsigned)(ck0 - cs) < 16u) ? (ck0 - cq + 15) : 31)) << (8 * (r & 3));
        bo1[r >> 2] |= (unsigned)(4 * (((unsigned)(ck1 - cs) < 16u) ? (ck1 - cq + 15) : 31)) << (8 * (r & 3)); }
    float m_reg = -1e30f, l_reg = 0.f; f32x16 o[4];
#pragma unroll
    for (int d = 0; d < 4; ++d)
#pragma unroll
        for (int r = 0; r < 16; ++r) o[d][r] = 0.f;
    ATT_SLOAD(0); ATT_SWRITE(0, 0); __syncthreads();
    const bool upper = ATT_STAGGER && wid >= 4; bool pend = false; int pvb = 0, vbuf = 0;
    bf16x8 pa0, pa1, pa2, pa3; { const v4u z_ = {0u, 0u, 0u, 0u}; pa0 = pa1 = pa2 = pa3 = __builtin_bit_cast(bf16x8, z_); }
    for (int jt = 0; jt < ntile; ++jt) {
        const int buf = jt & 1; const int vnext = (vbuf == 2) ? 0 : vbuf + 1;
        if (jt + 1 < ntile) ATT_SLOAD(jt + 1);
        if (upper && pend) { pv_one<0>(o[0], pvb, pa0, pa1, pa2, pa3); pv_one<1>(o[1], pvb, pa0, pa1, pa2, pa3); pv_one<2>(o[2], pvb, pa0, pa1, pa2, pa3); pv_one<3>(o[3], pvb, pa0, pa1, pa2, pa3); pend = false; }
        const bool islat = jt < nlat; const int kr = klo + jt;
        const bool active = !islat || (kr >= r0q && kr <= r0q + 7);
        if (active) {
            f32x16 p0, p1;
            if (islat) { const LAS unsigned char* trow = (const LAS unsigned char*)(TAB + (kr - rq + 7) * 32);
                asm volatile("" : "+v"(bo0[0]), "+v"(bo0[1]), "+v"(bo0[2]), "+v"(bo0[3]), "+v"(bo1[0]), "+v"(bo1[1]), "+v"(bo1[2]), "+v"(bo1[3]));
#pragma unroll
                for (int r = 0; r < 16; ++r) { p0[r] = *(const LAS float*)(trow + ((bo0[r >> 2] >> (8 * (r & 3))) & 0xffu)); p1[r] = *(const LAS float*)(trow + ((bo1[r >> 2] >> (8 * (r & 3))) & 0xffu)); } }
            else {
#pragma unroll
                for (int r = 0; r < 16; ++r) { p0[r] = 0.f; p1[r] = 0.f; } }
            LDS_WAIT();
            qkt_acc(p0, p1, K_lds + buf * SHM_K, qr, r32, hi);
            float pmax = p0[0];
#pragma unroll
            for (int r = 1; r < 16; ++r) pmax = fmaxf(pmax, p0[r]);
#pragma unroll
            for (int r = 0; r < 16; ++r) pmax = fmaxf(pmax, p1[r]);
#if ATT_PERM
            { unsigned pa_ = __builtin_bit_cast(unsigned, pmax), pb_ = pa_; asm volatile("" : "+v"(pb_));
              auto rr = __builtin_amdgcn_permlane32_swap(pa_, pb_, false, false);
              pmax = fmaxf(__builtin_bit_cast(float, rr[0]), __builtin_bit_cast(float, rr[1])); }
#else
            pmax = fmaxf(pmax, __shfl_xor(pmax, 32));
#endif
            float mn = m_reg, alpha = 1.f;
            if (!__all(pmax - m_reg <= 8.0f)) { mn = fmaxf(m_reg, pmax); alpha = __builtin_amdgcn_exp2f(m_reg - mn); m_reg = mn; }
            float ps = 0.f;
#pragma unroll
            for (int r = 0; r < 16; ++r) { p0[r] = __builtin_amdgcn_exp2f(p0[r] - mn); p1[r] = __builtin_amdgcn_exp2f(p1[r] - mn); ps += p0[r] + p1[r]; }
#if ATT_PERM
            { unsigned pa_ = __builtin_bit_cast(unsigned, ps), pb_ = pa_; asm volatile("" : "+v"(pb_));
              auto rr = __builtin_amdgcn_permlane32_swap(pa_, pb_, false, false);
              ps = __builtin_bit_cast(float, rr[0]) + __builtin_bit_cast(float, rr[1]); }
#else
            ps += __shfl_xor(ps, 32);
#endif
            l_reg = l_reg * alpha + ps;
            if (__any(alpha < 1.f)) { if (hi == 0) al_l[r32] = alpha; LDS_WAIT();
#pragma unroll
                for (int r = 0; r < 16; ++r) { const float a = al_l[crow(r, hi)];
#pragma unroll
                    for (int d = 0; d < 4; ++d) o[d][r] *= a; } }
#define ATT_PK4(P, BASE, OUT) do { const unsigned a0 = cvtpk(P[BASE + 0], P[BASE + 1]), a1 = cvtpk(P[BASE + 2], P[BASE + 3]); \
        const unsigned b0 = cvtpk(P[BASE + 4], P[BASE + 5]), b1 = cvtpk(P[BASE + 6], P[BASE + 7]); \
        auto r0_ = __builtin_amdgcn_permlane32_swap(a0, b0, false, false); auto r1_ = __builtin_amdgcn_permlane32_swap(a1, b1, false, false); \
        v4u w_ = {r0_[0], r1_[0], r0_[1], r1_[1]}; OUT = __builtin_bit_cast(bf16x8, w_); } while (0)
            ATT_PK4(p0, 0, pa0); ATT_PK4(p0, 8, pa1); ATT_PK4(p1, 0, pa2); ATT_PK4(p1, 8, pa3);
            const int vb = vb0 + vbuf * SHM_V;
            if (!upper) { pv_one<0>(o[0], vb, pa0, pa1, pa2, pa3); pv_one<1>(o[1], vb, pa0, pa1, pa2, pa3); pv_one<2>(o[2], vb, pa0, pa1, pa2, pa3); pv_one<3>(o[3], vb, pa0, pa1, pa2, pa3); }
            else { pend = true; pvb = vb; }
        }
        if (jt + 1 < ntile) ATT_SWRITE(buf ^ 1, vnext);
        vbuf = vnext;
        __syncthreads();
    }
    if (upper && pend) { pv_one<0>(o[0], pvb, pa0, pa1, pa2, pa3); pv_one<1>(o[1], pvb, pa0, pa1, pa2, pa3); pv_one<2>(o[2], pvb, pa0, pa1, pa2, pa3); pv_one<3>(o[3], pvb, pa0, pa1, pa2, pa3); }
    if (hi == 0) li_l[r32] = l_reg;
    LDS_WAIT();
    { const int lo_ = lane_now(), r32o = lo_ & 31, hio = lo_ >> 5;
      GAS bf16* Ow = (GAS bf16*)AO + (size_t)(qrow0 + 4 * hio) * DM + h * HD + r32o; const LAS float* lil = li_l + 4 * hio;
#pragma unroll
      for (int r = 0; r < 16; ++r) { const int orow = (r & 3) + 8 * (r >> 2); const float rl = __builtin_amdgcn_rcpf(lil[orow]);
#pragma unroll
          for (int d0 = 0; d0 < 4; ++d0) Ow[orow * DM + d0 * 32] = (bf16)(cvtpk(o[d0][r] * rl, 0.f) & 0xffffu); } }
    __syncthreads();
#undef ATT_KROW
#undef ATT_SLOAD
#undef ATT_SWRITE
#undef ATT_PK4
}
#undef PKLH
}

namespace sgm {
__device__ __forceinline__ void mix_unit(int n, int g, const bf16* U, const bf16* V, bf16* T, const float* ssp, const float* ws, const float* bs, const float* vgain, LAS unsigned char* lds, int tid, int wid, int lane) {
    using namespace att;
    const int r32 = lane & 31, hi = lane >> 5;
    LAS float* RST = (LAS float*)(lds + 131072);
    const int row0 = n * 128, colg = g * 512;
    if (tid < 128) { const GAS f32x4* sp = (const GAS f32x4*)((const GAS float*)ssp + (size_t)(row0 + tid) * 64); f32x4 s = sp[0];
#pragma unroll
        for (int j = 1; j < 16; ++j) s += sp[j];
        RST[tid] = 1.0f / sqrtf(((s.x + s.y) + (s.z + s.w)) * (1.0f / DM) + EPS); }
    { const int sr = tid >> 4, sc8 = (tid & 15) * 8, vst0 = v_st(sr, sc8), vst1 = v_st(32 + sr, sc8);
      v4u a[8], bq[8];
#pragma unroll
      for (int im = 0; im < 8; ++im) { const int kt = im >> 2, ct = im & 3; const GAS bf16* vp = (const GAS bf16*)V + (size_t)(row0 + kt * 64 + sr) * DM + colg + ct * 128 + sc8;
          a[im] = *(const GAS v4u*)vp; bq[im] = *(const GAS v4u*)(vp + (size_t)32 * DM); }
#pragma unroll
      for (int im = 0; im < 8; ++im) { *(LAS v4u*)(lds + im * SHM_V + vst0) = a[im]; *(LAS v4u*)(lds + im * SHM_V + vst1) = bq[im]; } }
    __syncthreads();
    const int pb = wid & 3, ch = wid >> 2;
    bf16x8 pa[8];
    { const GAS float* wp = (const GAS float*)ws + ((size_t)g * 128 + pb * 32 + r32) * 128 + hi * 8;
#pragma unroll
      for (int ks = 0; ks < 8; ++ks) { const f32x4 w0 = *(const GAS f32x4*)(wp + ks * 16), w1 = *(const GAS f32x4*)(wp + ks * 16 + 4); const LAS float* rs = RST + ks * 16 + hi * 8;
          v4u w; w.x = cvtpk(w0.x * rs[0], w0.y * rs[1]); w.y = cvtpk(w0.z * rs[2], w0.w * rs[3]); w.z = cvtpk(w1.x * rs[4], w1.y * rs[5]); w.w = cvtpk(w1.z * rs[6], w1.w * rs[7]);
          pa[ks] = __builtin_bit_cast(bf16x8, w); } }
    const float bsv = ((const GAS float*)bs)[g * 128 + pb * 32 + r32];
    const int vbl = (int)(uintptr_t)lds + v_rd_base(lane);
#pragma unroll
    for (int cc = 0; cc < 2; ++cc) { const int ct = 2 * ch + cc;
        f32x16 acc[4];
#pragma unroll
        for (int d = 0; d < 4; ++d)
#pragma unroll
            for (int r = 0; r < 16; ++r) acc[d][r] = 0.f;
#pragma unroll
        for (int kt = 0; kt < 2; ++kt) { const int vb = vbl + (kt * 4 + ct) * SHM_V;
            vt_one<0>(acc[0], vb, pa[kt * 4 + 0], pa[kt * 4 + 1], pa[kt * 4 + 2], pa[kt * 4 + 3]); vt_one<1>(acc[1], vb, pa[kt * 4 + 0], pa[kt * 4 + 1], pa[kt * 4 + 2], pa[kt * 4 + 3]);
            vt_one<2>(acc[2], vb, pa[kt * 4 + 0], pa[kt * 4 + 1], pa[kt * 4 + 2], pa[kt * 4 + 3]); vt_one<3>(acc[3], vb, pa[kt * 4 + 0], pa[kt * 4 + 1], pa[kt * 4 + 2], pa[kt * 4 + 3]); }
        const size_t rowoff = (size_t)(row0 + pb * 32 + r32) * DM + colg + ct * 128 + 4 * hi;
#pragma unroll
        for (int d0 = 0; d0 < 4; ++d0)
#pragma unroll
            for (int gq = 0; gq < 4; ++gq) { const size_t off = rowoff + d0 * 32 + gq * 8;
                const v2u uu = *(const GAS v2u*)((const GAS bf16*)U + off); const f32x4 vg = *(const GAS f32x4*)((const GAS float*)vgain + (off - (size_t)(row0 + pb * 32 + r32) * DM));
                v2u o; o.x = cvtpk(bf_lo(uu.x) * (vg.x * acc[d0][4 * gq + 0] + bsv), bf_hi(uu.x) * (vg.y * acc[d0][4 * gq + 1] + bsv));
                o.y = cvtpk(bf_lo(uu.y) * (vg.z * acc[d0][4 * gq + 2] + bsv), bf_hi(uu.y) * (vg.w * acc[d0][4 * gq + 3] + bsv));
                *(GAS v2u*)((GAS bf16*)T + off) = o; }
    }
    __syncthreads();
}
}

#ifndef MK_PER_PHASE
#define MK_PER_PHASE 0
#endif
constexpr int N_PHASES = 22;
#ifndef FUSE_MOD
#define FUSE_MOD 0
#endif
#ifndef XGTEST
#define XGTEST 0
#endif
#ifndef MOD_WAVES
#define MOD_WAVES 8
#endif
#ifndef CVT_WAVES
#define CVT_WAVES 4
#endif
static_assert(CVT_WAVES <= 7 && MK_PER_PHASE == 0 || !FUSE_MOD, "conversion scratch: 17920 B per wave inside the 132 KiB ring");
#ifndef PROBE_ORDER
#define PROBE_ORDER StaticOrder
#endif
#ifndef PROBE_PHASE
#define PROBE_PHASE -1
#endif
struct Args {
    const float *x, *c, *ctx, *cctx, *wada, *bada, *normg, *fwin, *fwout, *wqkv, *wo, *qgain, *kgain, *rpb, *sgwin, *sgbin, *sgvgain, *sgws, *sgbs, *sgwout;
    float* out; unsigned char* ws; int ph_lo, ph_hi;
};
__global__ void __launch_bounds__(NWAVES * 64, 2) fwd_kernel(Args args) {
    extern __shared__ __attribute__((aligned(16))) unsigned char lds_raw[];
    LAS unsigned char* lds = (LAS unsigned char*)lds_raw;
    volatile LAS unsigned* MISC = (volatile LAS unsigned*)(lds + MISC_OFF);
    const int wave = __builtin_amdgcn_readfirstlane(threadIdx.x >> 6);
    const int G = gridDim.x, bx = blockIdx.x;
#define LANE_TID() const int lane = lane_now(); const int tid = wave * 64 + lane; (void)tid
    const int vcu = (G % 8 == 0) ? (bx % 8) * (G / 8) + bx / 8 : bx;
    const int gw = vcu * NWAVES + wave, NGW = G * NWAVES;
    const int mgw = vcu * MOD_WAVES + wave, mNGW = G * MOD_WAVES;
    unsigned char* ws = args.ws;
    unsigned* ctl = (unsigned*)(ws + WS_CTL);
    float* MOD = (float*)(ws + WS_MOD); float* SSP = (float*)(ws + WS_SSP); float* PART = (float*)(ws + WS_PART);
    bf16* WIN = (bf16*)(ws + WS_WIN); bf16* WOUT = (bf16*)(ws + WS_WOUT); bf16* WQKV = (bf16*)(ws + WS_WQKV); bf16* WO = (bf16*)(ws + WS_WO);
    bf16* SGIN = (bf16*)(ws + WS_SGIN); bf16* SGOUT = (bf16*)(ws + WS_SGOUT);
    bf16* H = (bf16*)(ws + WS_H); bf16* ACT = (bf16*)(ws + WS_ACT); bf16* QKV = (bf16*)(ws + WS_QKV); bf16* AO = (bf16*)(ws + WS_AO);
    float* SWP = (float*)(ws + WS_SWP); float* SW = (float*)(ws + WS_SW); (void)SW;
    float* XSX = (float*)(ws + WS_XS); float* XSZ = XSX + (size_t)MX * DM;
        bf16* UB = (bf16*)(ws + WS_U); bf16* VB = (bf16*)(ws + WS_V); bf16* TB = (bf16*)(ws + WS_T);
    { LANE_TID(); for (int u = tid; u < (LDS_BYTES - MISC_OFF) / 4; u += NWAVES * 64) ((LAS unsigned*)(lds + MISC_OFF))[u] = 0u; }
    __syncthreads();
    XcdBarrier bar; bar.bar = ctl + CW_BAR; bar.x = 0; bar.st = nullptr;
    if (!MK_PER_PHASE) bar = xcd_barrier_post(ctl + CW_BAR, MISC + 8);
    const int lo = args.ph_lo, hi = args.ph_hi;
#define IN(k) (lo <= (k) && (k) < hi)
#define SEAM(k) do { if (!MK_PER_PHASE && IN(k) && IN((k) + 1)) xcd_barrier(bar); } while (0)
#define GEMM_PHASE(EpiT, Aptr, Bptr, Mv, Nv, Kv, ...) do { pg8::Gemm g_{(const pg8::bf16_t*)(Aptr), (const pg8::bf16_t*)(Bptr), (Mv), (Nv), (Kv), (Kv)}; pg8::StaticOrder S_; S_.init((Mv), (Nv), G, bx); \
        pg8::EpiT E_{__VA_ARGS__}; { LANE_TID(); pg8::gemm_phase<pg8::EpiT, pg8::StaticOrder, GK_ALIGN, GK_SP2>(lds, g_, S_, E_, tid); } } while (0)
#define RESID_PHASE(Aptr, Bptr, Kv, RIN, OUT, O_MODv, GSLOTv, GS2v, NGIDX, O_NMODv, NSLOTv, HASXG) do { typedef pg8::EpiResid<WS_XS, (O_MODv), WS_XB, WS_SSQ, (GSLOTv), (GS2v), WS_NG + (size_t)(NGIDX) * DM * 4, (O_NMODv), (NSLOTv), (HASXG)> Epi_; \
        pg8::Gemm g_{(const pg8::bf16_t*)(Aptr), (const pg8::bf16_t*)(Bptr), MX, DM, (Kv), (Kv)}; pg8::StaticOrder S_; S_.init(MX, DM, G, bx); Epi_ E_{ws, (RIN), (OUT)}; \
        { LANE_TID(); pg8::gemm_phase<Epi_, pg8::StaticOrder, GK_ALIGN, GK_SP2>(lds, g_, S_, E_, tid); } } while (0)
    constexpr size_t WS_MOD1 = WS_MOD + (size_t)5 * MODW * 4;
    const size_t WIN_SZ = (size_t)2 * DFF * DM, WOUT_SZ = (size_t)DM * DFF;

    for (int rep_ = 0; rep_ < ((PROBE_PHASE == 0) ? 2 : 1); ++rep_) { if (rep_) xcd_barrier(bar);
    if (IN(0)) { LANE_TID(); p_ada_partial(args.c, args.cctx, args.wada, PART, lds, vcu, G, tid, wave, lane); } } SEAM(0);
#define CVT_SET(NM, M0, M1, M2, M3, M4, M5, M6, RANK, NRANKS) do { const int mats_[7] = {M0, M1, M2, M3, M4, M5, M6}; int tot_ = 0; \
        _Pragma("unroll") for (int q_ = 0; q_ < (NM); ++q_) tot_ += cvt_items_of(mats_[q_]); \
        LAS float* scr_ = (LAS float*)(lds + wave * 17920); \
        for (int it_ = (RANK); it_ < tot_; it_ += (NRANKS)) { int r_ = it_, mat_ = mats_[0]; \
            _Pragma("unroll") for (int q_ = 0; q_ < (NM) - 1; ++q_) { const int n_ = cvt_items_of(mats_[q_]); if (mat_ == mats_[q_] && r_ >= n_) { r_ -= n_; mat_ = mats_[q_ + 1]; } } \
            const float* src_; bf16* dst_; int K_, N_; bool sw_ = false; const float* shv_ = nullptr; float* swp_ = nullptr; \
            if (mat_ < 4) { src_ = args.fwin + (size_t)mat_ * WIN_SZ; dst_ = WIN + (size_t)mat_ * WIN_SZ; K_ = DM; N_ = 2 * DFF; sw_ = true; \
                if (mat_ > 0) { shv_ = MOD + (size_t)(mat_ == 1 ? 0 : 5) * MODW + (size_t)(mat_ == 2 ? 0 : 6) * DM; swp_ = SWP + (size_t)64 * 5 * 3 * DM + (size_t)(mat_ - 1) * 64 * 5 * 2 * DFF; } } \
            else if (mat_ < 8) { src_ = args.fwout + (size_t)(mat_ - 4) * WOUT_SZ; dst_ = WOUT + (size_t)(mat_ - 4) * WOUT_SZ; K_ = DFF; N_ = DM; } \
            else if (mat_ == 8) { src_ = args.wqkv; dst_ = WQKV; K_ = DM; N_ = 3 * DM; shv_ = MOD + (size_t)3 * DM; swp_ = SWP; } \
            else if (mat_ == 9) { src_ = args.wo; dst_ = WO; K_ = DM; N_ = DM; } \
            else if (mat_ == 10) { src_ = args.sgwin; dst_ = SGIN; K_ = DM; N_ = 2 * DM; shv_ = MOD + (size_t)5 * MODW + (size_t)3 * DM; swp_ = SWP + (size_t)64 * 5 * 3 * DM + (size_t)3 * 64 * 5 * 2 * DFF; } \
            else { src_ = args.sgwout; dst_ = SGOUT; K_ = DM; N_ = DM; } \
            cvt_item(src_, K_, N_, dst_, sw_, scr_, r_, lane, FUSE_MOD ? shv_ : nullptr, swp_); } } while (0)
    for (int rep_ = 0; rep_ < ((PROBE_PHASE == 1) ? 2 : 1); ++rep_) { if (rep_) xcd_barrier(bar);
    if (IN(1)) { LANE_TID();
        p_mod_finalize(PART, args.bada, MOD, gw, NGW, lane); p_copy_normg(args.normg, (float*)(ws + WS_NG), gw, NGW, lane);
        if (FUSE_MOD && !MK_PER_PHASE) xcd_barrier(bar);
#if CVT_WAVES == 8
        CVT_SET(7, 0, 4, 2, 6, 10, 3, 7, gw, NGW); CVT_SET(3, 8, 9, 1, 1, 1, 1, 1, gw, NGW); CVT_SET(2, 5, 11, 11, 11, 11, 11, 11, gw, NGW);
#else
        if (wave < CVT_WAVES) { const int gw2 = vcu * CVT_WAVES + wave, ngw2 = G * CVT_WAVES;
        CVT_SET(7, 0, 4, 2, 6, 10, 3, 7, gw2, ngw2); CVT_SET(3, 8, 9, 1, 1, 1, 1, 1, gw2, ngw2); CVT_SET(2, 5, 11, 11, 11, 11, 11, 11, gw2, ngw2); }
#endif
    } } SEAM(1);
    for (int rep_ = 0; rep_ < ((PROBE_PHASE == 2) ? 2 : 1); ++rep_) { if (rep_) xcd_barrier(bar);
    if (IN(2)) { LANE_TID(); if (wave < MOD_WAVES) p_modulate(args.x, args.ctx, args.normg + 0 * DM, MOD, 0, H, MALL, mgw, mNGW, lane); if (FUSE_MOD) p_sw_reduce(SWP, SW, gw, NGW, lane); } } SEAM(2);
    for (int rep_ = 0; rep_ < ((PROBE_PHASE == 3) ? 2 : 1); ++rep_) { if (rep_) xcd_barrier(bar);
    if (IN(3)) { if (rep_ == 0) { GEMM_PHASE(EpiSwiGLU, H, WIN + 0 * WIN_SZ, MALL, 2 * DFF, DM, ACT, DFF); } else { pg8::Gemm g_{(const pg8::bf16_t*)H, (const pg8::bf16_t*)(WIN), MALL, 2 * DFF, DM, DM}; pg8::PROBE_ORDER S_; S_.init(MALL, 2 * DFF, G, bx); pg8::EpiNull E_{0}; { LANE_TID(); pg8::gemm_phase<pg8::EpiNull, pg8::PROBE_ORDER, GK_ALIGN, GK_SP2>(lds, g_, S_, E_, tid); } } } } SEAM(3);
    for (int rep_ = 0; rep_ < ((PROBE_PHASE == 4) ? 2 : 1); ++rep_) { if (rep_) xcd_barrier(bar);
    if (IN(4)) { RESID_PHASE(ACT, WOUT + 0 * WOUT_SZ, DFF, args.x, nullptr, WS_MOD, 2, 1, 1, WS_MOD, 4, XGTEST != 0);
        { pg8::Gemm g_{(const pg8::bf16_t*)ACT, (const pg8::bf16_t*)(WOUT), MALL, DM, 2048, DFF}; pg8::ZSplitOrder S_; S_.init(G, bx); pg8::EpiPart E_{(float*)(ws + WS_PARTZ)};
          { LANE_TID(); pg8::gemm_phase<pg8::EpiPart, pg8::ZSplitOrder, GK_ALIGN, GK_SP2>(lds, g_, S_, E_, tid); } } } } SEAM(4);
    for (int rep_ = 0; rep_ < ((PROBE_PHASE == 5) ? 2 : 1); ++rep_) { if (rep_) xcd_barrier(bar);
    if (IN(5)) { LANE_TID(); if (wave < MOD_WAVES) p_modulate_l0(XSX, args.ctx, (const float*)(ws + WS_PARTZ), args.normg + 1 * DM, MOD, 1, 2, H, mgw, mNGW, lane); } } SEAM(5);
    for (int rep_ = 0; rep_ < ((PROBE_PHASE == 6) ? 2 : 1); ++rep_) { if (rep_) xcd_barrier(bar);
    if (IN(6)) { pg8::Gemm g_{(const pg8::bf16_t*)H, (const pg8::bf16_t*)WQKV, MALL, 3 * DM, DM, DM}; pg8::QkvOrder S_; S_.init(G, bx); pg8::EpiBf16 E_{QKV, 3 * DM};
        { LANE_TID(); pg8::gemm_phase<pg8::EpiBf16, pg8::QkvOrder, GK_ALIGN, GK_SP2>(lds, g_, S_, E_, tid); } } } SEAM(6);
    for (int rep_ = 0; rep_ < ((PROBE_PHASE == 7) ? 2 : 1); ++rep_) { if (rep_) xcd_barrier(bar);
    if (IN(7)) { LANE_TID();
        for (int u = vcu; u < 1024; u += G) {
            att::attn_unit(true, u >> 8, (u >> 3) & 31, ((u & 7) + 2 * (u >> 8)) & 7, QKV, AO, args.qgain, args.kgain, args.rpb, lds, tid, wave, lane);
        }
    } } SEAM(7);
    if (IN(8)) { RESID_PHASE(AO, WO, DM, nullptr, nullptr, WS_MOD, 5, 2, 2, WS_MOD, 7, XGTEST != 0); } SEAM(8);
    if (IN(9)) { LANE_TID(); if (wave < MOD_WAVES) p_modulate(XSX, XSZ, args.normg + 2 * DM, MOD, 2, H, MX, mgw, mNGW, lane); } SEAM(9);
    if (IN(10)) { GEMM_PHASE(EpiSwiGLU, H, WIN + 1 * WIN_SZ, MX, 2 * DFF, DM, ACT, DFF); } SEAM(10);
    if (IN(11)) { RESID_PHASE(ACT, WOUT + 1 * WOUT_SZ, DFF, nullptr, nullptr, WS_MOD, 8, 1, 3, WS_MOD1, 1, XGTEST != 0); } SEAM(11);
    const float* MOD1 = MOD + 5 * MODW;
    for (int rep_ = 0; rep_ < ((PROBE_PHASE == 12) ? 2 : 1); ++rep_) { if (rep_) xcd_barrier(bar);
    if (IN(12)) { LANE_TID(); if (wave < MOD_WAVES) p_modulate(XSX, XSZ, args.normg + 3 * DM, MOD1, 0, H, MX, mgw, mNGW, lane); } } SEAM(12);
    for (int rep_ = 0; rep_ < ((PROBE_PHASE == 13) ? 2 : 1); ++rep_) { if (rep_) xcd_barrier(bar);
    if (IN(13)) { GEMM_PHASE(EpiSwiGLU, H, WIN + 2 * WIN_SZ, MX, 2 * DFF, DM, ACT, DFF); } } SEAM(13);
    if (IN(14)) { RESID_PHASE(ACT, WOUT + 2 * WOUT_SZ, DFF, nullptr, nullptr, WS_MOD1, 2, 1, 4, WS_MOD1, 4, XGTEST != 0); } SEAM(14);
    for (int rep_ = 0; rep_ < ((PROBE_PHASE == 15) ? 2 : 1); ++rep_) { if (rep_) xcd_barrier(bar);
    if (IN(15)) { LANE_TID(); if (wave < MOD_WAVES) p_modulate(XSX, XSZ, args.normg + 4 * DM, MOD1, 1, H, MX, mgw, mNGW, lane); } } SEAM(15);
    for (int rep_ = 0; rep_ < ((PROBE_PHASE == 16) ? 2 : 1); ++rep_) { if (rep_) xcd_barrier(bar);
    if (IN(16)) { GEMM_PHASE(EpiSG, H, SGIN, MX, 2 * DM, DM, UB, VB, args.sgbin, SSP); } } SEAM(16);
    for (int rep_ = 0; rep_ < ((PROBE_PHASE == 17) ? 2 : 1); ++rep_) { if (rep_) xcd_barrier(bar);
    if (IN(17)) { LANE_TID(); for (int u = vcu; u < 512; u += G) sgm::mix_unit(u >> 3, u & 7, UB, VB, TB, SSP, args.sgws, args.sgbs, args.sgvgain, lds, tid, wave, lane); } } SEAM(17);
    if (IN(18)) { RESID_PHASE(TB, SGOUT, DM, nullptr, nullptr, WS_MOD1, 5, 2, 5, WS_MOD1, 7, XGTEST != 0); } SEAM(18);
    if (IN(19)) { LANE_TID(); if (wave < MOD_WAVES) p_modulate(XSX, XSZ, args.normg + 5 * DM, MOD1, 2, H, MX, mgw, mNGW, lane); } SEAM(19);
    if (IN(20)) { GEMM_PHASE(EpiSwiGLU, H, WIN + 3 * WIN_SZ, MX, 2 * DFF, DM, ACT, DFF); } SEAM(20);
    if (IN(21)) { RESID_PHASE(ACT, WOUT + 3 * WOUT_SZ, DFF, nullptr, args.out, WS_MOD1, 8, 1, 0, WS_MOD1, 0, false); }
#undef IN
#undef SEAM
#undef GEMM_PHASE
#undef RESID_PHASE
#undef CVT_SET
#undef LANE_TID
}

extern "C" void kernel_launch(void* const* d_in, const int* in_sizes, int n_in, void* d_out, int out_size, void* d_ws, size_t ws_size, hipStream_t stream) {
    static int grid = 0;
    if (grid == 0) {
        if (n_in != 20 || in_sizes[0] != MX * DM || out_size != MX * DM || ws_size < WS_END) { fprintf(stderr, "kernel_launch: unexpected shapes (n_in %d, in0 %d, out %d, ws %zu)\n", n_in, n_in > 0 ? in_sizes[0] : -1, out_size, ws_size); grid = -1; return; }
        int dev = 0, cus = 0, per_cu = 0;
        if (hipGetDevice(&dev) != hipSuccess || hipDeviceGetAttribute(&cus, hipDeviceAttributeMultiprocessorCount, dev) != hipSuccess) { grid = -1; return; }
        if (hipFuncSetAttribute((const void*)fwd_kernel, hipFuncAttributeMaxDynamicSharedMemorySize, LDS_BYTES) != hipSuccess) { fprintf(stderr, "kernel_launch: hipFuncSetAttribute failed\n"); grid = -1; return; }
        if (hipOccupancyMaxActiveBlocksPerMultiprocessor(&per_cu, (const void*)fwd_kernel, NWAVES * 64, LDS_BYTES) != hipSuccess || per_cu < 1) fprintf(stderr, "kernel_launch: occupancy query reports %d\n", per_cu);
        (void)hipGetLastError();
        grid = cus;
    }
    if (grid < 0) return;
    if (hipMemsetAsync((char*)d_ws + WS_CTL, 0, CTL_ZERO_BYTES, stream) != hipSuccess) { fprintf(stderr, "kernel_launch: memset failed\n"); return; }
    Args a{};
    a.x = (const float*)d_in[0]; a.c = (const float*)d_in[1]; a.ctx = (const float*)d_in[2]; a.cctx = (const float*)d_in[3]; a.wada = (const float*)d_in[4]; a.bada = (const float*)d_in[5];
    a.normg = (const float*)d_in[6]; a.fwin = (const float*)d_in[7]; a.fwout = (const float*)d_in[8]; a.wqkv = (const float*)d_in[9]; a.wo = (const float*)d_in[10];
    a.qgain = (const float*)d_in[11]; a.kgain = (const float*)d_in[12]; a.rpb = (const float*)d_in[13]; a.sgwin = (const float*)d_in[14]; a.sgbin = (const float*)d_in[15];
    a.sgvgain = (const float*)d_in[16]; a.sgws = (const float*)d_in[17]; a.sgbs = (const float*)d_in[18]; a.sgwout = (const float*)d_in[19];
    a.out = (float*)d_out; a.ws = (unsigned char*)d_ws;
#if MK_PER_PHASE
    for (int p = 0; p < N_PHASES; ++p) { a.ph_lo = p; a.ph_hi = p + 1; hipLaunchKernelGGL(fwd_kernel, dim3(grid), dim3(NWAVES * 64), LDS_BYTES, stream, a); }
#else
    a.ph_lo = 0; a.ph_hi = N_PHASES; hipLaunchKernelGGL(fwd_kernel, dim3(grid), dim3(NWAVES * 64), LDS_BYTES, stream, a);
#endif
    const hipError_t le = hipPeekAtLastError();
    if (le != hipSuccess) fprintf(stderr, "kernel_launch: launch failed: %s\n", hipGetErrorName(le));
}
```

```cpp
#include <hip/hip_runtime.h>
#include <cstdio>
#include <cstdint>
#ifndef PG8_WGM
#define PG8_WGM 8
#endif
#ifndef GK_ALIGN
#define GK_ALIGN true
#endif
#ifndef PG8_FRESH
#define PG8_FRESH 0
#endif
#ifndef GK_SP2
#define GK_SP2 true
#endif
namespace pg8 {
#define PG8_LAS __attribute__((address_space(3)))
typedef unsigned short bf16_t;
typedef short bf16x8 __attribute__((ext_vector_type(8)));
typedef float f32x4 __attribute__((ext_vector_type(4)));
typedef unsigned u32x4 __attribute__((ext_vector_type(4)));
constexpr int BM = 256, BK = 64, HALF = 128, HTB = HALF * BK * 2  , STAGE_BYTES = 8 * HTB, NXCD = 8, WGM = PG8_WGM;

__host__ __device__ __forceinline__ int lds_byte(int r, int c) { const int st = (r >> 4) * 2 + (c >> 5), rr = r & 15, cc = c & 31, ob = rr * 64 + cc * 2; return st * 1024 + (ob ^ (((ob >> 9) & 1) << 5)); }
__host__ __device__ __forceinline__ void stage_rc(int b, int& R, int& C) { const int st = b / 1024, sb = b % 1024, swz = sb ^ (((sb >> 9) & 1) << 5); R = (st >> 1) * 16 + swz / 64; C = (st & 1) * 32 + (swz % 64) / 2; }
__host__ __device__ __forceinline__ int perm32(int rho) { const int n = rho >> 4, i = rho & 15; return 8 * (i >> 2) + 4 * n + (i & 3); }

struct Unit { int pm, pn, ko; };
struct Gemm { const bf16_t* A; const bf16_t* Bt; int M, N, K, ld; };

struct StaticOrder {
    int nM, nN, nwg, G, c;
    __host__ __device__ void init(int M, int N, int G_, int c_) { nM = M / BM; nN = N / BM; nwg = nM * nN; G = G_; c = c_; }
    __host__ __device__ bool next(int i, Unit& u) const {
        const long L = (long)i * G + c; if (L >= nwg) return false;
        int wgid = (int)L; { const int q = nwg / NXCD, r = nwg % NXCD, xcd = wgid % NXCD, off = wgid / NXCD; wgid = (xcd < r ? xcd * (q + 1) : r * (q + 1) + (xcd - r) * q) + off; }
        const int nig = WGM * nN, gid = wgid / nig, fm = gid * WGM, gsz = (nM - fm) < WGM ? (nM - fm) : WGM;
        u.pm = fm + ((wgid % nig) % gsz); u.pn = (wgid % nig) / gsz; u.ko = 0; return true;
    }
    __device__ __forceinline__ void a_ready(const Unit&) const {}
    __device__ __forceinline__ void done(const Unit&) const {}
};
struct QkvOrder {
    StaticOrder base; int nx;
    __host__ __device__ void init(int G_, int c_) { base.init(8192, 12288, G_, c_); nx = base.nwg; }
    __host__ __device__ bool next(int i, Unit& u) const {
        const long L = (long)i * base.G + base.c; if (L < nx) return base.next(i, u);
        const int l2 = (int)(L - nx); if (l2 >= 128) return false; u.pm = 32 + (l2 & 3); u.pn = 16 + (l2 >> 2); u.ko = 0; return true;
    }
    __device__ __forceinline__ void a_ready(const Unit&) const {}
    __device__ __forceinline__ void done(const Unit&) const {}
};
struct SameTileOrder {
    StaticOrder base;
    __host__ __device__ void init(int M, int N, int G_, int c_) { base.init(M, N, G_, c_); }
    __host__ __device__ bool next(int i, Unit& u) const { const bool ok = base.next(i, u); u.pm = 0; u.pn = 0; return ok; }
    __device__ __forceinline__ void a_ready(const Unit&) const {}
    __device__ __forceinline__ void done(const Unit&) const {}
};
struct ZSplitOrder {
    int G, c;
    __host__ __device__ void init(int G_, int c_) { G = G_; c = c_; }
    __host__ __device__ bool next(int i, Unit& u) const { const int s = i * G + c; if (s >= 256) return false; u.pm = 32 + ((s >> 2) & 3); u.pn = s >> 4; u.ko = (s & 3) * 2048 * 2; return true; }
    __device__ __forceinline__ void a_ready(const Unit&) const {}
    __device__ __forceinline__ void done(const Unit&) const {}
};

__device__ __forceinline__ unsigned cvt_pk_bf16(float lo, float hi) { unsigned r; asm volatile("v_cvt_pk_bf16_f32 %0, %1, %2" : "=v"(r) : "v"(lo), "v"(hi)); return r; }
__device__ __forceinline__ int lane_fresh() { int l; asm volatile("v_mbcnt_lo_u32_b32 %0, -1, 0\n\tv_mbcnt_hi_u32_b32 %0, -1, %0" : "=v"(l)); return l; }
typedef float f32x2 __attribute__((ext_vector_type(2)));
typedef unsigned u32x2 __attribute__((ext_vector_type(2)));
#define PG8_GAS __attribute__((address_space(1)))
#ifndef PROBE_EPI2
#define PROBE_EPI2 false
#endif

struct EpiBf16 {
    static constexpr bool PERM = true, AFTER_DRAIN = false, TWICE = false;
    bf16_t* O; int ldc;
    __device__ __forceinline__ void operator()(const f32x4 (&acc)[2][2][4][2], const Unit& u, int wr, int wc, int fr, int fq) const {
        const int row0 = u.pm * BM + wr * 64 + fr, col0 = u.pn * BM + wc * 32 + 8 * fq;
#pragma unroll
        for (int ai = 0; ai < 2; ++ai)
#pragma unroll
            for (int m = 0; m < 4; ++m) { bf16_t* rowp = O + (size_t)(row0 + ai * HALF + m * 16) * ldc + col0;
#pragma unroll
                for (int bj = 0; bj < 2; ++bj) { const f32x4 v0 = acc[ai][bj][m][0], v1 = acc[ai][bj][m][1];
                    u32x4 w; w.x = cvt_pk_bf16(v0[0], v0[1]); w.y = cvt_pk_bf16(v0[2], v0[3]); w.z = cvt_pk_bf16(v1[0], v1[1]); w.w = cvt_pk_bf16(v1[2], v1[3]);
                    *(PG8_GAS u32x4*)(rowp + bj * HALF) = w; } }
    }
};

__device__ __forceinline__ float silu_mul(float a, float g) { const float e = __builtin_amdgcn_exp2f(a * -1.4426950408889634f); return a * g * __builtin_amdgcn_rcpf(1.0f + e); }
struct EpiSwiGLU {
    static constexpr bool PERM = true, AFTER_DRAIN = false, TWICE = PROBE_EPI2;
    bf16_t* O; int ldc;
    __device__ __forceinline__ void operator()(const f32x4 (&acc)[2][2][4][2], const Unit& u, int wr, int wc, int fr, int fq) const {
        const int row0 = u.pm * BM + wr * 64 + fr, col0 = u.pn * HALF + wc * 32 + 8 * fq;
#pragma unroll
        for (int ai = 0; ai < 2; ++ai)
#pragma unroll
            for (int m = 0; m < 4; ++m) { bf16_t* rowp = O + (size_t)(row0 + ai * HALF + m * 16) * ldc + col0;
                const f32x4 a0 = acc[ai][0][m][0], a1 = acc[ai][0][m][1], g0 = acc[ai][1][m][0], g1 = acc[ai][1][m][1];
                u32x4 w; w.x = cvt_pk_bf16(silu_mul(a0[0], g0[0]), silu_mul(a0[1], g0[1])); w.y = cvt_pk_bf16(silu_mul(a0[2], g0[2]), silu_mul(a0[3], g0[3]));
                w.z = cvt_pk_bf16(silu_mul(a1[0], g1[0]), silu_mul(a1[1], g1[1])); w.w = cvt_pk_bf16(silu_mul(a1[2], g1[2]), silu_mul(a1[3], g1[3]));
                *(PG8_GAS u32x4*)rowp = w; }
    }
};

template <size_t O_XS, size_t O_MOD, size_t O_XG, size_t O_SSQ, int GSLOT, int GS2, size_t O_NG, size_t O_NMOD, int NSLOT, bool HAS_XG>
struct EpiResid {
    static constexpr bool PERM = true, AFTER_DRAIN = false, TWICE = false;
    unsigned char* ws;
    const float* rin; float* out;
    __device__ __forceinline__ void operator()(const f32x4 (&acc)[2][2][4][2], const Unit& u, int wr, int wc, int fr, int fq) const {
        unsigned long long w_ = (unsigned long long)ws; asm volatile("" : "+s"(w_));
        unsigned char* wsp = (unsigned char*)w_;
        float* xsx = (float*)(wsp + O_XS);
        const int bidx = u.pm >> 3;
        const int lrow0 = u.pm * BM + wr * 64 + fr, col0 = u.pn * BM + wc * 32 + 8 * fq, grow0 = u.pm * BM + wr * 64 + fr;
        const PG8_GAS float* ri = (const PG8_GAS float*)(rin ? rin : xsx); PG8_GAS float* ro = (PG8_GAS float*)(out ? out : xsx);
        const PG8_GAS float* gp = (const PG8_GAS float*)(wsp + O_MOD) + (size_t)bidx * 36864 + GSLOT * 4096 + col0;
        PG8_GAS bf16_t* xg = (PG8_GAS bf16_t*)(wsp + O_XG); PG8_GAS float* ssq = (PG8_GAS float*)(wsp + O_SSQ);
        f32x4 gv[2][2], nm[2][2], cur[2][2], nxt[2][2];
#pragma unroll
        for (int bj = 0; bj < 2; ++bj)
#pragma unroll
            for (int n = 0; n < 2; ++n) { gv[bj][n] = *(const PG8_GAS f32x4*)(gp + bj * HALF + n * 4) * (0.5f * GS2); cur[bj][n] = *(const PG8_GAS f32x4*)(ri + (size_t)lrow0 * 4096 + col0 + bj * HALF + n * 4);
                nm[bj][n] = (f32x4){0.f, 0.f, 0.f, 0.f};
                if (HAS_XG) { const f32x4 g_ = *(const PG8_GAS f32x4*)((const PG8_GAS float*)(wsp + O_NG) + col0 + bj * HALF + n * 4);
                    const f32x4 s_ = *(const PG8_GAS f32x4*)((const PG8_GAS float*)(wsp + O_NMOD) + (size_t)bidx * 36864 + NSLOT * 4096 + col0 + bj * HALF + n * 4); nm[bj][n] = g_ * (s_ + 1.0f); } }
#pragma unroll
        for (int g = 0; g < 8; ++g) { const int ai = g >> 2, m = g & 3; const size_t off = (size_t)(lrow0 + ai * HALF + m * 16) * 4096 + col0, goff = (size_t)(grow0 + ai * HALF + m * 16) * 4096 + col0; float ss = 0.f;
            if (g < 7) { const size_t offn = (size_t)(lrow0 + ((g + 1) >> 2) * HALF + ((g + 1) & 3) * 16) * 4096 + col0;
#pragma unroll
                for (int bj = 0; bj < 2; ++bj)
#pragma unroll
                    for (int n = 0; n < 2; ++n) nxt[bj][n] = *(const PG8_GAS f32x4*)(ri + offn + bj * HALF + n * 4); }
#pragma unroll
            for (int bj = 0; bj < 2; ++bj) { const f32x4 y0 = cur[bj][0] + gv[bj][0] * acc[ai][bj][m][0], y1 = cur[bj][1] + gv[bj][1] * acc[ai][bj][m][1];
                *(PG8_GAS f32x4*)(ro + off + bj * HALF) = y0; *(PG8_GAS f32x4*)(ro + off + bj * HALF + 4) = y1;
                if (HAS_XG) { ss += ((y0[0] * y0[0] + y0[1] * y0[1]) + (y0[2] * y0[2] + y0[3] * y0[3])) + ((y1[0] * y1[0] + y1[1] * y1[1]) + (y1[2] * y1[2] + y1[3] * y1[3]));
                    const f32x4 z0 = y0 * nm[bj][0], z1 = y1 * nm[bj][1]; u32x4 w; w.x = cvt_pk_bf16(z0[0], z0[1]); w.y = cvt_pk_bf16(z0[2], z0[3]); w.z = cvt_pk_bf16(z1[0], z1[1]); w.w = cvt_pk_bf16(z1[2], z1[3]);
                    *(PG8_GAS u32x4*)(xg + goff + bj * HALF) = w; } }
            if (HAS_XG) { ss += __shfl_xor(ss, 16); ss += __shfl_xor(ss, 32);
                if (fq == 0) ssq[(size_t)(grow0 + ai * HALF + m * 16) * 64 + u.pn * 4 + wc] = ss; }
            asm volatile("" ::: "memory");
#pragma unroll
            for (int bj = 0; bj < 2; ++bj)
#pragma unroll
                for (int n = 0; n < 2; ++n) cur[bj][n] = nxt[bj][n]; }
    }
};

struct EpiPart {
    static constexpr bool PERM = false, AFTER_DRAIN = false, TWICE = false;
    float* P;
    __device__ __forceinline__ void operator()(const f32x4 (&acc)[2][2][4][2], const Unit& u, int wr, int wc, int fr, int fq) const {
        const int lrow0 = (u.pm - 32) * BM + wr * 64 + fr, col0 = u.pn * BM + wc * 32 + 4 * fq;
        PG8_GAS float* po = (PG8_GAS float*)P + (size_t)(u.ko >> 12) * 1024 * 4096;
#pragma unroll
        for (int ai = 0; ai < 2; ++ai)
#pragma unroll
            for (int m = 0; m < 4; ++m) { const size_t off = (size_t)(lrow0 + ai * HALF + m * 16) * 4096 + col0;
#pragma unroll
                for (int bj = 0; bj < 2; ++bj)
#pragma unroll
                    for (int n = 0; n < 2; ++n) *(PG8_GAS f32x4*)(po + off + bj * HALF + n * 16) = acc[ai][bj][m][n]; }
    }
};

__device__ __forceinline__ float gelu_tanh(float x) { const float t = x * (1.0f + 0.044715f * x * x) * -2.3022081918882205f;
    return x * __builtin_amdgcn_rcpf(1.0f + __builtin_amdgcn_exp2f(t)); }
struct EpiSG {
    static constexpr bool PERM = true, AFTER_DRAIN = false, TWICE = false;
    bf16_t* U; bf16_t* V; const float* bias; float* ssp;
    __device__ __forceinline__ void operator()(const f32x4 (&acc)[2][2][4][2], const Unit& u, int wr, int wc, int fr, int fq) const {
        const bool isv = u.pn >= 16; const int row0 = u.pm * BM + wr * 64 + fr, colt = (isv ? u.pn - 16 : u.pn) * BM, col0 = colt + wc * 32 + 8 * fq, bcol0 = u.pn * BM + wc * 32 + 8 * fq;
        bf16_t* base = isv ? V : U;
        f32x4 bv[2][2];
#pragma unroll
        for (int bj = 0; bj < 2; ++bj)
#pragma unroll
            for (int n = 0; n < 2; ++n) bv[bj][n] = *(const PG8_GAS f32x4*)((const PG8_GAS float*)bias + bcol0 + bj * HALF + 4 * n);
#pragma unroll
        for (int ai = 0; ai < 2; ++ai)
#pragma unroll
            for (int m = 0; m < 4; ++m) { bf16_t* rowp = base + (size_t)(row0 + ai * HALF + m * 16) * 4096 + col0; float ss = 0.f;
#pragma unroll
                for (int bj = 0; bj < 2; ++bj) { f32x4 v0 = acc[ai][bj][m][0] + bv[bj][0], v1 = acc[ai][bj][m][1] + bv[bj][1];
#pragma unroll
                    for (int j = 0; j < 4; ++j) { v0[j] = gelu_tanh(v0[j]); v1[j] = gelu_tanh(v1[j]); ss += v0[j] * v0[j] + v1[j] * v1[j]; }
                    u32x4 w; w.x = cvt_pk_bf16(v0[0], v0[1]); w.y = cvt_pk_bf16(v0[2], v0[3]); w.z = cvt_pk_bf16(v1[0], v1[1]); w.w = cvt_pk_bf16(v1[2], v1[3]);
                    *(PG8_GAS u32x4*)(rowp + bj * HALF) = w; }
                if (isv) { ss += __shfl_xor(ss, 16); ss += __shfl_xor(ss, 32);
                    if (fq == 0) ((PG8_GAS float*)ssp)[(size_t)(row0 + ai * HALF + m * 16) * 64 + (u.pn - 16) * 4 + wc] = ss; } }
    }
};

struct EpiNull {
    static constexpr bool PERM = true, AFTER_DRAIN = false, TWICE = false;
    int dummy;
    __device__ __forceinline__ void operator()(const f32x4 (&acc)[2][2][4][2], const Unit& u, int wr, int wc, int fr, int fq) const {
#pragma unroll
        for (int ai = 0; ai < 2; ++ai)
#pragma unroll
            for (int bj = 0; bj < 2; ++bj)
#pragma unroll
                for (int m = 0; m < 4; ++m)
#pragma unroll
                    for (int n = 0; n < 2; ++n) asm volatile("" :: "v"(acc[ai][bj][m][n]));
    }
};
template <class Epi, class Sched, bool ALIGN_EPI = false, bool SP2 = false>
__device__ __forceinline__ void gemm_phase(PG8_LAS unsigned char* lds, const Gemm g, const Sched& S, const Epi& E, const int tid) {
    const int wid = __builtin_amdgcn_readfirstlane(tid >> 6), lane = tid & 63, wr = wid >> 2, wc = wid & 3, fr = lane & 15, fq = lane >> 4;
    const int K = g.ld, nt = g.K / BK;
    unsigned voffA[2], voffB[2];
#pragma unroll
    for (int i = 0; i < 2; ++i) { int R, C; stage_rc(tid * 16 + i * 8192, R, C); const int Rb = Epi::PERM ? ((R & ~31) + perm32(R & 31)) : R;
        voffA[i] = (unsigned)(R * K + C) * 2u; voffB[i] = (unsigned)(Rb * K + C) * 2u; }
    const size_t kstep = (size_t)(BK * 2);
    const size_t hstep = (size_t)HALF * K * 2;
    const size_t tstep = 2 * hstep;
    const unsigned ldsw = (unsigned)wid * 1024u;
    const int aoff = lds_byte(wr * 64 + fr, fq * 8), boff = lds_byte(wc * 32 + fr, fq * 8);
#define PG8_SA(b, h) (((b) * 2 + (h)) * HTB)
#define PG8_SB(b, h) ((4 + (b) * 2 + (h)) * HTB)
#define PG8_STAGE(bufoff, gbase, voff) do { _Pragma("unroll") for (int _i = 0; _i < 2; ++_i) \
        __builtin_amdgcn_global_load_lds((const unsigned*)((const char*)(gbase) + (voff)[_i]), (PG8_LAS unsigned*)(lds + (bufoff) + ldsw + _i * 8192), 16, 0, 0); } while (0)
#define PG8_LDA(dst, b, h) do { _Pragma("unroll") for (int m = 0; m < 4; ++m) _Pragma("unroll") for (int k = 0; k < 2; ++k) dst[m][k] = *(const PG8_LAS bf16x8*)(lds + PG8_SA(b, h) + aoff + m * 2048 + k * 1024); } while (0)
#define PG8_LDB(dst, b, h) do { _Pragma("unroll") for (int n = 0; n < 2; ++n) _Pragma("unroll") for (int k = 0; k < 2; ++k) dst[n][k] = *(const PG8_LAS bf16x8*)(lds + PG8_SB(b, h) + boff + n * 2048 + k * 1024); } while (0)
#define PG8_MMA(ai, bj, At, Bt) do { __builtin_amdgcn_s_setprio(1); _Pragma("unroll") for (int m = 0; m < 4; ++m) _Pragma("unroll") for (int n = 0; n < 2; ++n) _Pragma("unroll") for (int k = 0; k < 2; ++k) \
        acc[ai][bj][m][n] = __builtin_amdgcn_mfma_f32_16x16x32_bf16(Bt[n][k], At[m][k], acc[ai][bj][m][n], 0, 0, 0); __builtin_amdgcn_s_setprio(0); } while (0)
#define PG8_WAIT_V(n) asm volatile("s_waitcnt vmcnt(" #n ")" ::: "memory")
#define PG8_WAIT_L(n) asm volatile("s_waitcnt lgkmcnt(" #n ")" ::: "memory")
#define PG8_BAR __builtin_amdgcn_s_barrier()
#define PG8_SCHED __builtin_amdgcn_sched_barrier(0)
    Unit cur, nxt; int ui = 0;
    if (!S.next(0, cur)) return;
    f32x4 acc[2][2][4][2];
#pragma unroll
    for (int a = 0; a < 2; ++a)
#pragma unroll
        for (int b = 0; b < 2; ++b)
#pragma unroll
            for (int m = 0; m < 4; ++m)
#pragma unroll
                for (int n = 0; n < 2; ++n) acc[a][b][m][n] = (f32x4){0.f, 0.f, 0.f, 0.f};
    bf16x8 At[4][2], B0[2][2], B1[2][2];
    const char* cA = (const char*)g.A + (size_t)cur.pm * tstep + cur.ko; const char* cB = (const char*)g.Bt + (size_t)cur.pn * tstep + cur.ko;
    S.a_ready(cur);
    if constexpr (SP2) {
        PG8_STAGE(PG8_SB(0, 0), cB, voffB); PG8_STAGE(PG8_SB(0, 1), cB + hstep, voffB); PG8_STAGE(PG8_SA(0, 0), cA, voffA); PG8_STAGE(PG8_SA(0, 1), cA + hstep, voffA);
        if (wr == 1) PG8_BAR;
        PG8_WAIT_V(2); PG8_BAR;
        PG8_STAGE(PG8_SB(1, 0), cB + kstep, voffB); PG8_STAGE(PG8_SA(1, 0), cA + kstep, voffA); PG8_STAGE(PG8_SB(1, 1), cB + hstep + kstep, voffB);
        PG8_WAIT_V(6); PG8_BAR;
    } else {
        PG8_STAGE(PG8_SB(0, 0), cB, voffB); PG8_STAGE(PG8_SA(0, 0), cA, voffA); PG8_STAGE(PG8_SB(0, 1), cB + hstep, voffB); PG8_STAGE(PG8_SA(0, 1), cA + hstep, voffA);
        if (wr == 1) PG8_BAR;
        PG8_WAIT_V(4); PG8_BAR;
        PG8_STAGE(PG8_SB(1, 0), cB + kstep, voffB); PG8_STAGE(PG8_SA(1, 0), cA + kstep, voffA); PG8_STAGE(PG8_SB(1, 1), cB + hstep + kstep, voffB);
        PG8_WAIT_V(6); PG8_BAR;
    }
    for (;;) {
        const bool has_next = S.next(ui + 1, nxt);
        const char* nA = has_next ? (const char*)g.A + (size_t)nxt.pm * tstep + nxt.ko : cA; const char* nB = has_next ? (const char*)g.Bt + (size_t)nxt.pn * tstep + nxt.ko : cB;
        for (int t = 0; t < nt; t += 2) {
            const bool last = (t == nt - 2);
            const char* a1 = cA + (size_t)(t + 1) * kstep;
            const char* a2 = last ? nA : cA + (size_t)(t + 2) * kstep; const char* b2 = last ? nB : cB + (size_t)(t + 2) * kstep;
            const char* a3 = a2 + kstep; const char* b3 = b2 + kstep;
            if (last && has_next) S.a_ready(nxt);
            if constexpr (SP2) {
            PG8_LDB(B0, 0, 0); PG8_LDB(B1, 0, 1); PG8_SCHED; PG8_LDA(At, 0, 0); PG8_STAGE(PG8_SA(1, 1), a1 + hstep, voffA);
            PG8_WAIT_V(8); PG8_WAIT_L(0); PG8_BAR; PG8_MMA(0, 0, At, B0); PG8_MMA(0, 1, At, B1); PG8_BAR; PG8_SCHED;
            PG8_LDA(At, 0, 1); PG8_STAGE(PG8_SB(0, 0), b2, voffB); PG8_STAGE(PG8_SB(0, 1), b2 + hstep, voffB); PG8_STAGE(PG8_SA(0, 0), a2, voffA);
            PG8_WAIT_V(8); PG8_WAIT_L(0); PG8_BAR; PG8_MMA(1, 0, At, B0); PG8_MMA(1, 1, At, B1); PG8_BAR; PG8_SCHED;
            PG8_LDB(B0, 1, 0); PG8_LDB(B1, 1, 1); PG8_SCHED; PG8_LDA(At, 1, 0); PG8_STAGE(PG8_SA(0, 1), a2 + hstep, voffA);
            PG8_WAIT_V(8); PG8_WAIT_L(0); PG8_BAR; PG8_MMA(0, 0, At, B0); PG8_MMA(0, 1, At, B1); PG8_BAR; PG8_SCHED;
            PG8_LDA(At, 1, 1); PG8_STAGE(PG8_SB(1, 0), b3, voffB); PG8_STAGE(PG8_SB(1, 1), b3 + hstep, voffB); PG8_STAGE(PG8_SA(1, 0), a3, voffA);
            PG8_WAIT_V(8); PG8_WAIT_L(0); PG8_BAR; PG8_MMA(1, 0, At, B0); PG8_MMA(1, 1, At, B1); PG8_BAR; PG8_SCHED;
            } else {
            PG8_LDB(B0, 0, 0); PG8_SCHED; PG8_LDA(At, 0, 0); PG8_STAGE(PG8_SA(1, 1), a1 + hstep, voffA);
            PG8_WAIT_L(8); PG8_BAR; PG8_WAIT_L(0); PG8_MMA(0, 0, At, B0); PG8_BAR; PG8_SCHED;
            PG8_LDB(B1, 0, 1); PG8_STAGE(PG8_SB(0, 0), b2, voffB);
            PG8_BAR; PG8_WAIT_L(0); PG8_MMA(0, 1, At, B1); PG8_BAR;
            PG8_LDA(At, 0, 1); PG8_STAGE(PG8_SA(0, 0), a2, voffA);
            PG8_BAR; PG8_WAIT_L(0); PG8_MMA(1, 0, At, B0); PG8_BAR; PG8_SCHED;
            PG8_STAGE(PG8_SB(0, 1), b2 + hstep, voffB);
            PG8_WAIT_V(6); PG8_BAR; PG8_MMA(1, 1, At, B1); PG8_BAR;
            PG8_LDB(B0, 1, 0); PG8_SCHED; PG8_LDA(At, 1, 0); PG8_STAGE(PG8_SA(0, 1), a2 + hstep, voffA);
            PG8_WAIT_L(8); PG8_BAR; PG8_WAIT_L(0); PG8_MMA(0, 0, At, B0); PG8_BAR; PG8_SCHED;
            PG8_LDB(B1, 1, 1); PG8_STAGE(PG8_SB(1, 0), b3, voffB);
            PG8_BAR; PG8_WAIT_L(0); PG8_MMA(0, 1, At, B1); PG8_BAR;
            PG8_LDA(At, 1, 1); PG8_STAGE(PG8_SA(1, 0), a3, voffA);
            PG8_BAR; PG8_WAIT_L(0); PG8_MMA(1, 0, At, B0); PG8_BAR; PG8_SCHED;
            PG8_STAGE(PG8_SB(1, 1), b3 + hstep, voffB);
            PG8_WAIT_V(6); PG8_BAR; PG8_MMA(1, 1, At, B1); PG8_BAR;
            }
        }
        if constexpr (ALIGN_EPI) { if (wr == 0) PG8_BAR; }
        if constexpr (!Epi::AFTER_DRAIN) { const int le_ = PG8_FRESH ? lane_fresh() : lane; E(acc, cur, wr, wc, le_ & 15, le_ >> 4);
            if constexpr (Epi::TWICE) { asm volatile("" ::: "memory"); E(acc, cur, wr, wc, le_ & 15, le_ >> 4); } S.done(cur); }
        if (!has_next) break;
#pragma unroll
        for (int a = 0; a < 2; ++a)
#pragma unroll
            for (int b = 0; b < 2; ++b)
#pragma unroll
                for (int m = 0; m < 4; ++m)
#pragma unroll
                    for (int n = 0; n < 2; ++n) acc[a][b][m][n] = (f32x4){0.f, 0.f, 0.f, 0.f};
        cur = nxt; cA = nA; cB = nB; ++ui;
        if constexpr (ALIGN_EPI) { if (wr == 1) PG8_BAR; }
    }
    PG8_WAIT_V(0);
    if constexpr (!ALIGN_EPI) { if (wr == 0) PG8_BAR; }
    PG8_BAR;
    if constexpr (Epi::AFTER_DRAIN) { E.fused(acc, cur, wr, wc, fr, fq, lds, wid, lane); S.done(cur); }
#undef PG8_SA
#undef PG8_SB
#undef PG8_STAGE
#undef PG8_LDA
#undef PG8_LDB
#undef PG8_MMA
#undef PG8_WAIT_V
#undef PG8_WAIT_L
#undef PG8_BAR
#undef PG8_SCHED
}
}

constexpr int DM = 4096, NB = 4, SEQ = 2048, CTX = 256, GW = 64, NH = 32, HD = 128, DFF = 8192, NMOD = 9;
constexpr int MX = NB * SEQ, MZ = NB * CTX, MALL = MX + MZ;
constexpr int MODW = NMOD * DM;
constexpr float EPS = 1e-6f, LOG2E = 1.4426950408889634f;
constexpr int KSPLIT = 8;

constexpr size_t MiB = 1u << 20;
constexpr size_t WS_CTL = 0, CTL_ZERO_BYTES = 1 * MiB;
constexpr size_t WS_MOD  = 2 * MiB;
constexpr size_t WS_SSP  = 4 * MiB;
constexpr size_t WS_NG   = 28 * MiB;
constexpr size_t WS_SSQ  = 29 * MiB;
constexpr size_t WS_PART = 8 * MiB;
constexpr size_t WS_WIN  = 32 * MiB;
constexpr size_t WS_WOUT = WS_WIN + 4 * 128 * MiB;
constexpr size_t WS_WQKV = WS_WOUT + 4 * 64 * MiB;
constexpr size_t WS_WO   = WS_WQKV + 96 * MiB;
constexpr size_t WS_SGIN = WS_WO + 32 * MiB;
constexpr size_t WS_SGOUT = WS_SGIN + 64 * MiB;
constexpr size_t WS_H    = WS_SGOUT + 32 * MiB;
constexpr size_t WS_ACT  = WS_H + 72 * MiB;
constexpr size_t WS_QKV  = WS_ACT + 144 * MiB;
constexpr size_t WS_AO   = WS_QKV + 216 * MiB;
constexpr size_t WS_XS   = WS_AO + 72 * MiB;
constexpr size_t WS_U    = WS_XS + 144 * MiB;
constexpr size_t WS_V    = WS_U + 64 * MiB;
constexpr size_t WS_T    = WS_V + 64 * MiB;
constexpr size_t WS_XB   = WS_T + 64 * MiB;
constexpr size_t WS_PARTZ = WS_XB + 72 * MiB;
constexpr size_t WS_SWP  = WS_PARTZ + 64 * MiB;
constexpr size_t WS_SW   = WS_SWP + 96 * MiB;
constexpr size_t WS_END  = WS_SW + 2 * MiB;
constexpr int CW_BAR = 4096;

constexpr int RING_BYTES = 135168;
constexpr int MISC_OFF = RING_BYTES;
constexpr int LDS_BYTES = 139264;
constexpr int NWAVES = 8;

#define GAS __attribute__((address_space(1)))
#define LAS __attribute__((address_space(3)))
typedef unsigned short bf16;
typedef unsigned v4u __attribute__((ext_vector_type(4)));
typedef unsigned v2u __attribute__((ext_vector_type(2)));
typedef float f32x4 __attribute__((ext_vector_type(4)));
typedef float f32x16 __attribute__((ext_vector_type(16)));
typedef short bf16x8 __attribute__((ext_vector_type(8)));
typedef short s16x4 __attribute__((ext_vector_type(4)));
#define LDS_WAIT() asm volatile("s_waitcnt lgkmcnt(0)" ::: "memory")
#define VM_WAIT() asm volatile("s_waitcnt vmcnt(0)" ::: "memory")
#define SBAR() __builtin_amdgcn_sched_barrier(0)
__device__ __forceinline__ unsigned cvtpk(float lo, float hi) { unsigned r; asm volatile("v_cvt_pk_bf16_f32 %0, %1, %2" : "=v"(r) : "v"(lo), "v"(hi)); return r; }
__device__ __forceinline__ float bf_lo(unsigned w) { return __builtin_bit_cast(float, w << 16); }
__device__ __forceinline__ float bf_hi(unsigned w) { return __builtin_bit_cast(float, w & 0xffff0000u); }
__device__ __forceinline__ float wave_sum(float v) {
#pragma unroll
    for (int o = 1; o < 64; o <<= 1) v += __shfl_xor(v, o);
    return v;
}
__device__ __forceinline__ int lane_now() { int l; asm volatile("v_mbcnt_lo_u32_b32 %0, -1, 0\n\tv_mbcnt_hi_u32_b32 %0, -1, %0" : "=v"(l)); return l; }
__device__ __forceinline__ void swap32(unsigned& a, unsigned& b) { asm volatile("s_nop 1\n\tv_permlane32_swap_b32 %0, %1" : "+v"(a), "+v"(b)); }
#define XB_TMO      128
#define XB_XCNT(j)  (256  + 64 * (j))
#define XB_XSUB(j)  (1280 + 64 * (j))
#define XB_XGEN(j)  (2304 + 64 * (j))
#define XB_TOP      3328
#define XB_TOPGEN   3392
#define XCD_BAR_WORDS 3456
#define XB_SPIN_CAP (1u << 18)

__device__ __forceinline__ unsigned xb_ld(unsigned* p)              { return __hip_atomic_load(p, __ATOMIC_RELAXED, __HIP_MEMORY_SCOPE_AGENT); }
__device__ __forceinline__ unsigned xb_add(unsigned* p, unsigned v) { return __hip_atomic_fetch_add(p, v, __ATOMIC_RELAXED, __HIP_MEMORY_SCOPE_AGENT); }
__device__ __forceinline__ unsigned xb_xcc_id() { return (unsigned)__builtin_amdgcn_s_getreg((3 << 11) | 20) & 0xFu; }
#define XB_SPIN(cond, bar) do { unsigned _sp = 0; while (cond) { __builtin_amdgcn_s_sleep(1); \
    if ((++_sp & 255u) == 0u) { if (xb_ld(&(bar)[XB_TMO])) break; if (_sp > XB_SPIN_CAP) { atomicAdd(&(bar)[XB_TMO], 1u); break; } } } } while (0)

struct XcdBarrier {
    unsigned* bar; unsigned x;
    volatile LAS unsigned* st;
};

__device__ __forceinline__ XcdBarrier xcd_barrier_post(unsigned* bar, volatile LAS unsigned* st) {
    XcdBarrier b; b.bar = bar; b.x = xb_xcc_id(); b.st = st;
    if (threadIdx.x == 0) (void)xb_add(&bar[XB_XCNT(b.x)], 1u);
    return b;
}
__device__ __forceinline__ void xcd_barrier_complete(unsigned* bar, unsigned x, unsigned& nloc, unsigned& nx) {
    const unsigned G = gridDim.x * gridDim.y * gridDim.z;
    unsigned sum, cnt, mine, sp = 0u;
    for (;;) {
        sum = 0u; cnt = 0u; mine = 0u;
#pragma unroll
        for (unsigned j = 0; j < 16; ++j) { const unsigned c = xb_ld(&bar[XB_XCNT(j)]); sum += c; cnt += (c > 0u) ? 1u : 0u; mine = (j == x) ? c : mine; }
        if (sum == G) break;
        __builtin_amdgcn_s_sleep(1);
        if ((++sp & 255u) == 0u) { if (xb_ld(&bar[XB_TMO])) break; if (sp > XB_SPIN_CAP) { atomicAdd(&bar[XB_TMO], 1u); break; } }
    }
    nloc = mine > 0u ? mine : 1u; nx = cnt > 0u ? cnt : 1u;
}

__device__ __forceinline__ void xcd_barrier(const XcdBarrier& b) {
    asm volatile("s_waitcnt vmcnt(0)" ::: "memory");
    __syncthreads();
    if (threadIdx.x == 0) {
        unsigned* bar = b.bar;
        __builtin_amdgcn_s_waitcnt(0);
        unsigned nloc = b.st[0], nx = b.st[1];
        if (nloc == 0u) { xcd_barrier_complete(bar, b.x, nloc, nx); b.st[0] = nloc; b.st[1] = nx; }
        const unsigned old = xb_add(&bar[XB_XSUB(b.x)], 1u);
        const unsigned gen = old / nloc;
        if (old + 1u == (gen + 1u) * nloc) {
            __builtin_amdgcn_fence(__ATOMIC_RELEASE, "agent");
            asm volatile("s_waitcnt vmcnt(0)" ::: "memory");
            const unsigned og = xb_add(&bar[XB_TOP], 1u);
            const unsigned tg = og / nx;
            if (og + 1u == (tg + 1u) * nx) xb_add(&bar[XB_TOPGEN], 1u);
            else XB_SPIN(xb_ld(&bar[XB_TOPGEN]) == tg, bar);
            __builtin_amdgcn_fence(__ATOMIC_ACQUIRE, "agent");
            xb_add(&bar[XB_XGEN(b.x)], 1u);
            asm volatile("s_waitcnt vmcnt(0)" ::: "memory");
        } else {
            XB_SPIN(xb_ld(&bar[XB_XGEN(b.x)]) == gen, bar);
            __builtin_amdgcn_fence(__ATOMIC_ACQUIRE, "agent");
            asm volatile("s_waitcnt vmcnt(0)" ::: "memory");
        }
    }
    __syncthreads();
}

#ifndef ADA_WAVES
#define ADA_WAVES 8
#endif
__device__ __forceinline__ void p_ada_partial(const float* c, const float* cctx, const float* wada, float* part, LAS unsigned char* lds, int vcu, int G, int tid, int wave, int lane) {
    constexpr int KW = DM / KSPLIT / ADA_WAVES;
    LAS float* sil = (LAS float*)(lds + 65536) + wave * (5 * KW);
    LAS float* red = (LAS float*)lds;
    constexpr int NITEM = 2 * (MODW / 256) * KSPLIT;
    for (int it = vcu; it < NITEM; it += G) {
        const int i = it / ((MODW / 256) * KSPLIT), rem = it % ((MODW / 256) * KSPLIT), cg = rem / KSPLIT, ks = rem % KSPLIT;
        const int k0 = ks * (DM / KSPLIT) + wave * KW;
        if (wave < ADA_WAVES) {
        const GAS float* wp = (const GAS float*)wada + ((size_t)i * DM + k0) * MODW + cg * 256 + 4 * lane;
        f32x4 wA[16], wB[16];
#pragma unroll
        for (int j = 0; j < 16; ++j) wA[j] = __builtin_nontemporal_load((const GAS f32x4*)(wp + (size_t)j * MODW));
#pragma unroll
        for (int j = 0; j < 5 * KW / 64; ++j) { const int idx = lane + 64 * j; const int r = idx / KW, kk = idx % KW;
            const float x = (r < 4) ? ((const GAS float*)c)[r * DM + k0 + kk] : ((const GAS float*)cctx)[k0 + kk];
            sil[idx] = x * __builtin_amdgcn_rcpf(1.0f + __builtin_amdgcn_exp2f(-x * LOG2E)); }
        f32x4 acc[5];
#pragma unroll
        for (int r = 0; r < 5; ++r) acc[r] = (f32x4){0.f, 0.f, 0.f, 0.f};
        LDS_WAIT();
#pragma unroll
        for (int hb = 0; hb < KW / 16; hb += 2) {
#pragma unroll
            for (int j = 0; j < 16; ++j) wB[j] = __builtin_nontemporal_load((const GAS f32x4*)(wp + (size_t)((hb + 1) * 16 + j) * MODW));
#pragma unroll
            for (int j = 0; j < 16; ++j)
#pragma unroll
                for (int r = 0; r < 5; ++r) acc[r] += wA[j] * sil[r * KW + hb * 16 + j];
            if (hb + 2 < KW / 16) {
#pragma unroll
                for (int j = 0; j < 16; ++j) wA[j] = __builtin_nontemporal_load((const GAS f32x4*)(wp + (size_t)((hb + 2) * 16 + j) * MODW)); }
#pragma unroll
            for (int j = 0; j < 16; ++j)
#pragma unroll
                for (int r = 0; r < 5; ++r) acc[r] += wB[j] * sil[r * KW + (hb + 1) * 16 + j];
        }
#pragma unroll
        for (int r = 0; r < 5; ++r) *(LAS f32x4*)(red + (wave * 5 + r) * 256 + 4 * lane) = acc[r];
        }
        __syncthreads();
        if (tid < 320) { const int r = tid >> 6, c4 = tid & 63; f32x4 s = (f32x4){0.f, 0.f, 0.f, 0.f};
#pragma unroll
            for (int w = 0; w < ADA_WAVES; ++w) s += *(LAS f32x4*)(red + (w * 5 + r) * 256 + 4 * c4);
            *(GAS f32x4*)((GAS float*)part + ((size_t)(ks * 5 + r) * 2 + i) * MODW + cg * 256 + 4 * c4) = s; }
        __syncthreads();
    }
}
__device__ __forceinline__ void p_mod_finalize(const float* part, const float* bada, float* mod, int gw, int NGW, int lane) {
    constexpr int N4 = 2 * 5 * MODW / 4;
    for (int idx = gw * 64 + lane; idx < N4; idx += NGW * 64) {
        const int e = idx * 4, i = e / (5 * MODW), r = (e / MODW) % 5, col = e % MODW;
        f32x4 s = *(const GAS f32x4*)((const GAS float*)bada + (size_t)i * MODW + col);
#pragma unroll
        for (int ks = 0; ks < KSPLIT; ++ks) s += *(const GAS f32x4*)((const GAS float*)part + ((size_t)(ks * 5 + r) * 2 + i) * MODW + col);
        *(GAS f32x4*)((GAS float*)mod + (size_t)(i * 5 + r) * MODW + col) = s;
    }
}
__device__ __forceinline__ void p_copy_normg(const float* normg, float* ng, int gw, int NGW, int lane) {
    for (int idx = gw * 64 + lane; idx < 6 * DM / 4; idx += NGW * 64) ((GAS f32x4*)ng)[idx] = ((const GAS f32x4*)normg)[idx];
}
#ifndef CVT_NTSTORE
#define CVT_NTSTORE 0
#endif
#ifndef CVT_KFAST
#define CVT_KFAST 0
#endif
__device__ __forceinline__ unsigned f2bf(float f) { unsigned u = __builtin_bit_cast(unsigned, f); return (u + 0x7fffu + ((u >> 16) & 1u)) >> 16; }
__device__ __forceinline__ unsigned pk2(float lo, float hi) { return f2bf(lo) | (f2bf(hi) << 16); }
__device__ __forceinline__ void cvt_item(const float* W, int K, int N, bf16* WT, bool swiglu, LAS float* scr, int item, int lane, const float* shiftv, float* swp) {
    #if CVT_KFAST
    const int kblk = K >> 6, nb = item / kblk, kb = item - nb * kblk, k0 = kb << 6, n0 = nb << 6;
#else
    const int nblk = N >> 6, kb = item / nblk, nb = item - kb * nblk, k0 = kb << 6, n0 = nb << 6;
#endif
    const int c4 = lane & 15, rr = lane >> 4;
    const GAS float* src = (const GAS float*)W + (size_t)(k0 + rr) * N + n0 + 4 * c4;
    f32x4 v[16];
#pragma unroll
    for (int j = 0; j < 16; ++j) v[j] = __builtin_nontemporal_load((const GAS f32x4*)(src + (size_t)(4 * j) * N));
#pragma unroll
    for (int j = 0; j < 16; ++j) { LAS float* d = scr + (4 * j + rr) * 65 + 4 * c4; d[0] = v[j].x; d[1] = v[j].y; d[2] = v[j].z; d[3] = v[j].w; }
    int vrow0 = n0;
    if (swiglu) { const int half = N >> 1; vrow0 = (n0 < half) ? (((n0 >> 7) << 8) + (n0 & 127)) : ((((n0 - half) >> 7) << 8) + 128 + ((n0 - half) & 127)); }
    if (shiftv) { LAS float* shl = scr + 64 * 65;
#pragma unroll
        for (int b = 0; b < 5; ++b) shl[b * 64 + lane] = ((const GAS float*)shiftv)[(size_t)b * MODW + k0 + lane];
        LDS_WAIT(); asm volatile("" ::: "memory");
        f32x4 sa[5];
#pragma unroll
        for (int b = 0; b < 5; ++b) { sa[b] = (f32x4){0.f, 0.f, 0.f, 0.f};
#pragma unroll
            for (int j = 0; j < 16; ++j) sa[b] += v[j] * shl[b * 64 + 4 * j + rr]; }
#pragma unroll
        for (int b = 0; b < 5; ++b) {
#pragma unroll
            for (int e = 0; e < 4; ++e) { float t = sa[b][e]; t += __shfl_xor(t, 16); t += __shfl_xor(t, 32); sa[b][e] = t; }
            if (rr == 0) *(GAS f32x4*)((GAS float*)swp + ((size_t)kb * 5 + b) * N + vrow0 + 4 * c4) = sa[b]; } }
    LDS_WAIT(); asm volatile("" ::: "memory");
    const int c8 = lane & 7;
#pragma unroll
    for (int j2 = 0; j2 < 8; ++j2) { const int n = (lane >> 3) + 8 * j2; const LAS float* s = scr + (8 * c8) * 65 + n;
        v4u o; o.x = cvtpk(s[0 * 65], s[1 * 65]); o.y = cvtpk(s[2 * 65], s[3 * 65]); o.z = cvtpk(s[4 * 65], s[5 * 65]); o.w = cvtpk(s[6 * 65], s[7 * 65]);
#if CVT_NTSTORE
        __builtin_nontemporal_store(o, (GAS v4u*)((GAS bf16*)WT + (size_t)(vrow0 + n) * K + k0 + 8 * c8)); }
#else
        *(GAS v4u*)((GAS bf16*)WT + (size_t)(vrow0 + n) * K + k0 + 8 * c8) = o; }
#endif
    LDS_WAIT(); asm volatile("" ::: "memory");
}
__device__ __forceinline__ constexpr int cvt_items_of(int mat) { return mat < 4 ? (DM / 64) * (2 * DFF / 64) : mat < 8 ? (DFF / 64) * (DM / 64) : mat == 8 ? (DM / 64) * (3 * DM / 64) : mat == 10 ? (DM / 64) * (2 * DM / 64) : (DM / 64) * (DM / 64); }
__device__ __forceinline__ void p_modulate(const float* xs_x, const float* xs_z, const float* gain, const float* modl, int j, bf16* H, int M, int gw, int NGW, int lane) {
    for (int m = gw; m < M; m += NGW) {
        const bool isx = m < MX; const int bidx = isx ? (m >> 11) : 4;
        const GAS f32x4* xr = (const GAS f32x4*)((isx ? (const GAS float*)xs_x + (size_t)m * DM : (const GAS float*)xs_z + (size_t)(m - MX) * DM)) + lane;
        const GAS f32x4* gp = (const GAS f32x4*)((const GAS float*)gain) + lane;
        const GAS f32x4* shp = (const GAS f32x4*)((const GAS float*)modl + (size_t)bidx * MODW + (3 * j) * DM) + lane;
        const GAS f32x4* scp = (const GAS f32x4*)((const GAS float*)modl + (size_t)bidx * MODW + (3 * j + 1) * DM) + lane;
        f32x4 v[16]; float s = 0.f;
#pragma unroll
        for (int q = 0; q < 16; ++q) { v[q] = xr[64 * q]; s += (v[q].x * v[q].x + v[q].y * v[q].y) + (v[q].z * v[q].z + v[q].w * v[q].w); }
        const float rstd = 1.0f / sqrtf(wave_sum(s) * (1.0f / DM) + EPS);
        GAS v2u* o8 = (GAS v2u*)((GAS bf16*)H + (size_t)m * DM) + lane;
#pragma unroll
        for (int q = 0; q < 16; ++q) { const f32x4 g = gp[64 * q], sc = scp[64 * q], sh = shp[64 * q];
            const f32x4 y = v[q] * rstd * g * (sc + 1.0f) + sh; v2u o; o.x = cvtpk(y.x, y.y); o.y = cvtpk(y.z, y.w); o8[64 * q] = o; }
    }
}
__device__ __forceinline__ void p_modulate_b(const bf16* XB, const float* ssq, const float* gain, const float* modl, int j, bf16* H, int M, int gw, int NGW, int lane) {
    for (int m = gw; m < M; m += NGW) {
        const int bidx = (m < MX) ? (m >> 11) : 4;
        const GAS v4u* xr = (const GAS v4u*)((const GAS bf16*)XB + (size_t)m * DM) + lane;
        v4u v[8];
#pragma unroll
        for (int q = 0; q < 8; ++q) v[q] = xr[64 * q];
        const float rstd = 1.0f / sqrtf(wave_sum(((const GAS float*)ssq)[(size_t)m * 64 + lane]) * (1.0f / DM) + EPS);
        const GAS f32x4* gp = (const GAS f32x4*)((const GAS float*)gain) + 2 * lane;
        const GAS f32x4* shp = (const GAS f32x4*)((const GAS float*)modl + (size_t)bidx * MODW + (3 * j) * DM) + 2 * lane;
        const GAS f32x4* scp = (const GAS f32x4*)((const GAS float*)modl + (size_t)bidx * MODW + (3 * j + 1) * DM) + 2 * lane;
        GAS v4u* o16 = (GAS v4u*)((GAS bf16*)H + (size_t)m * DM) + lane;
#pragma unroll
        for (int q = 0; q < 8; ++q) { const f32x4 g0 = gp[128 * q], g1 = gp[128 * q + 1], c0 = scp[128 * q], c1 = scp[128 * q + 1], h0 = shp[128 * q], h1 = shp[128 * q + 1];
            const f32x4 x0 = (f32x4){bf_lo(v[q].x), bf_hi(v[q].x), bf_lo(v[q].y), bf_hi(v[q].y)}, x1 = (f32x4){bf_lo(v[q].z), bf_hi(v[q].z), bf_lo(v[q].w), bf_hi(v[q].w)};
            const f32x4 y0 = x0 * rstd * g0 * (c0 + 1.0f) + h0, y1 = x1 * rstd * g1 * (c1 + 1.0f) + h1;
            v4u o; o.x = cvtpk(y0.x, y0.y); o.y = cvtpk(y0.z, y0.w); o.z = cvtpk(y1.x, y1.y); o.w = cvtpk(y1.z, y1.w); o16[64 * q] = o; }
    }
}
__device__ __forceinline__ void p_modulate_l0(const float* xs_x, const float* ctx, const float* partz, const float* gain, const float* modl, int j, int gslot, bf16* H, int gw, int NGW, int lane) {
    const int nrows = (NGW == 2048) ? (gw < 1024 ? 4 : 5) : (MALL + NGW - 1) / NGW;
    for (int it = 0; it < nrows; ++it) {
        int m;
        if (NGW == 2048) m = (gw < 1024) ? (it == 0 ? MX + gw : gw * 3 + it - 1) : 3072 + (gw - 1024) * 5 + it;
        else { m = gw + it * NGW; if (m >= MALL) break; }
        const bool isx = m < MX; const int bidx = isx ? (m >> 11) : 4;
        const GAS f32x4* gp = (const GAS f32x4*)((const GAS float*)gain) + lane;
        const GAS f32x4* shp = (const GAS f32x4*)((const GAS float*)modl + (size_t)bidx * MODW + (3 * j) * DM) + lane;
        const GAS f32x4* scp = (const GAS f32x4*)((const GAS float*)modl + (size_t)bidx * MODW + (3 * j + 1) * DM) + lane;
        f32x4 v[16]; float s = 0.f;
        if (isx) { const GAS f32x4* xr = (const GAS f32x4*)((const GAS float*)xs_x + (size_t)m * DM) + lane;
#pragma unroll
            for (int q = 0; q < 16; ++q) v[q] = xr[64 * q]; }
        else { const size_t zo = (size_t)(m - MX) * DM; const GAS f32x4* cr = (const GAS f32x4*)((const GAS float*)ctx + zo) + lane;
            const GAS f32x4* gt = (const GAS f32x4*)((const GAS float*)modl + (size_t)4 * MODW + gslot * DM) + lane; const GAS f32x4* pz = (const GAS f32x4*)((const GAS float*)partz + zo) + lane;
#pragma unroll
            for (int q = 0; q < 16; ++q) { const f32x4 p = (pz[64 * q] + pz[64 * q + (size_t)MZ * DM / 4]) + (pz[64 * q + (size_t)2 * MZ * DM / 4] + pz[64 * q + (size_t)3 * MZ * DM / 4]);
                v[q] = cr[64 * q] + gt[64 * q] * 0.5f * p; } }
#pragma unroll
        for (int q = 0; q < 16; ++q) s += (v[q].x * v[q].x + v[q].y * v[q].y) + (v[q].z * v[q].z + v[q].w * v[q].w);
        const float rstd = 1.0f / sqrtf(wave_sum(s) * (1.0f / DM) + EPS);
        GAS v2u* o8 = (GAS v2u*)((GAS bf16*)H + (size_t)m * DM) + lane;
#pragma unroll
        for (int q = 0; q < 16; ++q) { const f32x4 g = gp[64 * q], sc = scp[64 * q], sh = shp[64 * q];
            const f32x4 y = v[q] * rstd * g * (sc + 1.0f) + sh; v2u o; o.x = cvtpk(y.x, y.y); o.y = cvtpk(y.z, y.w); o8[64 * q] = o; }
    }
}
__device__ __forceinline__ void p_sw_reduce(const float* swp, float* sw, int gw, int NGW, int lane) {
    for (int idx = gw * 64 + lane; idx < 5 * 5 * 4096; idx += NGW * 64) {
        const int m = idx / (5 * 4096), b = (idx / 4096) % 5, c4 = idx % 4096; const int N = (m == 0) ? 3 * DM : (m == 4) ? 2 * DM : 2 * DFF;
        if (4 * c4 >= N) continue;
        const size_t mbase = (m == 0) ? 0 : (size_t)64 * 5 * 3 * DM + (size_t)(m - 1) * 64 * 5 * 2 * DFF;
        const GAS f32x4* sp = (const GAS f32x4*)((const GAS float*)swp + mbase + (size_t)b * N) + c4; f32x4 a = (f32x4){0.f, 0.f, 0.f, 0.f};
#pragma unroll 8
        for (int kb = 0; kb < 64; ++kb) a += sp[(size_t)kb * 5 * N / 4];
        *(GAS f32x4*)((GAS float*)sw + ((size_t)m * 5 + b) * 16384 + 4 * c4) = a;
    }
}

#ifndef ATT_STAGGER
#define ATT_STAGGER 0
#endif
#ifndef ATT_PERM
#define ATT_PERM 1
#endif
#ifndef ATT_DPP
#define ATT_DPP 1
#endif
namespace att {
constexpr int SHM_K = 16384, SHM_V = 16384;
constexpr int OFF_V = 0, OFF_K = 3 * SHM_V, OFF_TAB = OFF_K + 2 * SHM_K, OFF_WS = OFF_TAB + 2048;
#define KSWZ(row, colB) ((row) * 256 + ((colB) ^ (((row) & 7) << 4)))
__device__ __forceinline__ int crow(int r, int hi) { return (r & 3) + 8 * (r >> 2) + 4 * hi; }
__device__ __forceinline__ int v_st(int k, int c) { const int kk = (k & ~0xC) | ((k & 4) << 1) | ((k & 8) >> 1); return ((kk >> 3) * 4 + (c >> 5)) * 512 + ((kk & 7) * 32 + (c & 31)) * 2; }
__device__ __forceinline__ int v_rd_base(int lane) { return ((lane & 3) << 3) | (((lane >> 2) & 3) << 6) | (((lane >> 4) & 1) << 5) | (((lane >> 5) & 1) << 8); }
constexpr int v_rd_off(int d0, int ks, int half) { return d0 * 512 + ks * 4096 + half * 2048; }
template <int OFF> __device__ __forceinline__ s16x4 tr_read(int vb) {
    s16x4 r; asm volatile("ds_read_b64_tr_b16 %0, %1 offset:%2" : "=&v"(r) : "v"(vb), "i"(OFF) : "memory"); return r;
}
template <int D0> __device__ __forceinline__ void pv_one(f32x16& od, int vb, bf16x8 pa0, bf16x8 pa1, bf16x8 pa2, bf16x8 pa3) {
    const s16x4 l0 = tr_read<v_rd_off(D0, 0, 0)>(vb), h0 = tr_read<v_rd_off(D0, 0, 1)>(vb), l1 = tr_read<v_rd_off(D0, 1, 0)>(vb), h1 = tr_read<v_rd_off(D0, 1, 1)>(vb);
    const s16x4 l2 = tr_read<v_rd_off(D0, 2, 0)>(vb), h2 = tr_read<v_rd_off(D0, 2, 1)>(vb), l3 = tr_read<v_rd_off(D0, 3, 0)>(vb), h3 = tr_read<v_rd_off(D0, 3, 1)>(vb);
    asm volatile("s_waitcnt lgkmcnt(0)" ::: "memory"); SBAR();
#define PKLH(L, H) (bf16x8){L[0], L[1], L[2], L[3], H[0], H[1], H[2], H[3]}
    od = __builtin_amdgcn_mfma_f32_32x32x16_bf16(pa0, PKLH(l0, h0), od, 0, 0, 0);
    od = __builtin_amdgcn_mfma_f32_32x32x16_bf16(pa1, PKLH(l1, h1), od, 0, 0, 0);
    od = __builtin_amdgcn_mfma_f32_32x32x16_bf16(pa2, PKLH(l2, h2), od, 0, 0, 0);
    od = __builtin_amdgcn_mfma_f32_32x32x16_bf16(pa3, PKLH(l3, h3), od, 0, 0, 0);
}
template <int D0> __device__ __forceinline__ void vt_one(f32x16& od, int vb, bf16x8 pa0, bf16x8 pa1, bf16x8 pa2, bf16x8 pa3) {
    const s16x4 l0 = tr_read<v_rd_off(D0, 0, 0)>(vb), h0 = tr_read<v_rd_off(D0, 0, 1)>(vb), l1 = tr_read<v_rd_off(D0, 1, 0)>(vb), h1 = tr_read<v_rd_off(D0, 1, 1)>(vb);
    const s16x4 l2 = tr_read<v_rd_off(D0, 2, 0)>(vb), h2 = tr_read<v_rd_off(D0, 2, 1)>(vb), l3 = tr_read<v_rd_off(D0, 3, 0)>(vb), h3 = tr_read<v_rd_off(D0, 3, 1)>(vb);
    asm volatile("s_waitcnt lgkmcnt(0)" ::: "memory"); SBAR();
    od = __builtin_amdgcn_mfma_f32_32x32x16_bf16(PKLH(l0, h0), pa0, od, 0, 0, 0);
    od = __builtin_amdgcn_mfma_f32_32x32x16_bf16(PKLH(l1, h1), pa1, od, 0, 0, 0);
    od = __builtin_amdgcn_mfma_f32_32x32x16_bf16(PKLH(l2, h2), pa2, od, 0, 0, 0);
    od = __builtin_amdgcn_mfma_f32_32x32x16_bf16(PKLH(l3, h3), pa3, od, 0, 0, 0);
}
__device__ __forceinline__ void qkt_acc(f32x16& p0, f32x16& p1, const LAS unsigned char* Ks, const bf16x8* qr, int r32, int hi) {
#pragma unroll
    for (int d0 = 0; d0 < 8; ++d0) { const int cb = (d0 * 16 + hi * 8) * 2;
        const bf16x8 b0 = *(const LAS bf16x8*)(Ks + KSWZ(r32, cb));
        const bf16x8 b1 = *(const LAS bf16x8*)(Ks + KSWZ(32 + r32, cb));
        p0 = __builtin_amdgcn_mfma_f32_32x32x16_bf16(b0, qr[d0], p0, 0, 0, 0);
        p1 = __builtin_amdgcn_mfma_f32_32x32x16_bf16(b1, qr[d0], p1, 0, 0, 0); }
}
__device__ __forceinline__ bf16x8 knorm8(v4u raw, const float (&kg)[8]) {
    float x[8]; x[0] = bf_lo(raw.x); x[1] = bf_hi(raw.x); x[2] = bf_lo(raw.y); x[3] = bf_hi(raw.y); x[4] = bf_lo(raw.z); x[5] = bf_hi(raw.z); x[6] = bf_lo(raw.w); x[7] = bf_hi(raw.w);
    float ss = 0.f;
#pragma unroll
    for (int j = 0; j < 8; ++j) ss += x[j] * x[j];
#if ATT_DPP
    ss += __builtin_bit_cast(float, __builtin_amdgcn_update_dpp(0, __builtin_bit_cast(int, ss), 0xB1, 0xF, 0xF, true));
    ss += __builtin_bit_cast(float, __builtin_amdgcn_update_dpp(0, __builtin_bit_cast(int, ss), 0x4E, 0xF, 0xF, true));
    ss += __builtin_bit_cast(float, __builtin_amdgcn_update_dpp(0, __builtin_bit_cast(int, ss), 0x141, 0xF, 0xF, true));
    ss += __builtin_bit_cast(float, __builtin_amdgcn_update_dpp(0, __builtin_bit_cast(int, ss), 0x140, 0xF, 0xF, true));
#else
    ss += __shfl_xor(ss, 1); ss += __shfl_xor(ss, 2); ss += __shfl_xor(ss, 4); ss += __shfl_xor(ss, 8);
#endif
    const float rstd = 1.0f / sqrtf(ss * (1.0f / HD) + EPS);
    v4u w; w.x = cvtpk(x[0] * rstd * kg[0], x[1] * rstd * kg[1]); w.y = cvtpk(x[2] * rstd * kg[2], x[3] * rstd * kg[3]);
    w.z = cvtpk(x[4] * rstd * kg[4], x[5] * rstd * kg[5]); w.w = cvtpk(x[6] * rstd * kg[6], x[7] * rstd * kg[7]);
    return __builtin_bit_cast(bf16x8, w);
}
__device__ __forceinline__ void attn_unit(bool lat, int b, int h, int rg, const bf16* QKV, bf16* AO, const float* qgain, const float* kgain, const float* rpb, LAS unsigned char* lds, int tid, int wid, int lane) {
    const int r32 = lane & 31, hi = lane >> 5;
    LAS unsigned char* V_lds = lds + OFF_V; LAS unsigned char* K_lds = lds + OFF_K; LAS float* TAB = (LAS float*)(lds + OFF_TAB);
    LAS float* wsl = (LAS float*)(lds + OFF_WS) + wid * 64; LAS float* li_l = wsl; LAS float* al_l = wsl + 32;
    constexpr int LDQ = 3 * DM;
    const int rq = 4 * rg + (wid >> 1);
    const int klo = lat ? min(max(4 * rg - 4, 0), 24) : 0, khi = lat ? min(max(4 * rg - 1, 0), 24) + 7 : -1, nlat = khi - klo + 1, ntile = nlat + 4;
    const int r0q = min(max(rq - 4, 0), 24);
    const int qrow0 = lat ? b * SEQ + 64 * rq + 32 * (wid & 1) : MX + b * CTX + 32 * wid;
    const int cq = 32 * (wid & 1) + r32, cs = min(max(cq - 8, 0), 48);
    if (lat && tid < 480) { const int i = tid & 31; TAB[tid] = (i < 31) ? ((const GAS float*)rpb)[h * 465 + (tid >> 5) * 31 + i] * LOG2E : -1e30f; }
    bf16x8 qr[8];
    { const GAS bf16* Qp = (const GAS bf16*)QKV + (size_t)(qrow0 + r32) * LDQ + h * HD + hi * 8;
      v4u raw[8]; float ss = 0.f;
#pragma unroll
      for (int d0 = 0; d0 < 8; ++d0) { raw[d0] = *(const GAS v4u*)(Qp + d0 * 16);
          const float a0 = bf_lo(raw[d0].x), a1 = bf_hi(raw[d0].x), a2 = bf_lo(raw[d0].y), a3 = bf_hi(raw[d0].y), a4 = bf_lo(raw[d0].z), a5 = bf_hi(raw[d0].z), a6 = bf_lo(raw[d0].w), a7 = bf_hi(raw[d0].w);
          ss += (a0 * a0 + a1 * a1) + (a2 * a2 + a3 * a3) + (a4 * a4 + a5 * a5) + (a6 * a6 + a7 * a7); }
      ss += __shfl_xor(ss, 32);
      const float sc = (1.0f / sqrtf(ss * (1.0f / HD) + EPS)) * (0.08838834764831845f * LOG2E);
#pragma unroll
      for (int d0 = 0; d0 < 8; ++d0) { const GAS f32x4* gq = (const GAS f32x4*)((const GAS float*)qgain + d0 * 16 + hi * 8); const f32x4 g0 = gq[0], g1 = gq[1];
          v4u w; w.x = cvtpk(bf_lo(raw[d0].x) * sc * g0.x, bf_hi(raw[d0].x) * sc * g0.y); w.y = cvtpk(bf_lo(raw[d0].y) * sc * g0.z, bf_hi(raw[d0].y) * sc * g0.w);
          w.z = cvtpk(bf_lo(raw[d0].z) * sc * g1.x, bf_hi(raw[d0].z) * sc * g1.y); w.w = cvtpk(bf_lo(raw[d0].w) * sc * g1.z, bf_hi(raw[d0].w) * sc * g1.w);
          qr[d0] = __builtin_bit_cast(bf16x8, w); } }
    const int sr = tid >> 4, sc8 = (tid & 15) * 8, vst0 = v_st(sr, sc8), vst1 = v_st(32 + sr, sc8), kst0 = KSWZ(sr, sc8 * 2), kst1 = KSWZ(32 + sr, sc8 * 2);
    float kg[8];
    { const GAS f32x4* gk = (const GAS f32x4*)((const GAS float*)kgain + sc8); const f32x4 g0 = gk[0], g1 = gk[1]; kg[0] = g0.x; kg[1] = g0.y; kg[2] = g0.z; kg[3] = g0.w; kg[4] = g1.x; kg[5] = g1.y; kg[6] = g1.z; kg[7] = g1.w; }
    const int vb0 = (int)(uintptr_t)V_lds + v_rd_base(lane);
    v4u ks0, ks1, vs0, vs1;
#define ATT_KROW(jt) ((jt) < nlat ? b * SEQ + 64 * (klo + (jt)) : MX + b * CTX + 64 * ((jt) - nlat))
#define ATT_SLOAD(jt) do { const GAS bf16* kp = (const GAS bf16*)QKV + (size_t)(ATT_KROW(jt) + sr) * LDQ + DM + h * HD + sc8; \
        ks0 = *(const GAS v4u*)kp; ks1 = *(const GAS v4u*)(kp + (size_t)32 * LDQ); vs0 = *(const GAS v4u*)(kp + DM); vs1 = *(const GAS v4u*)(kp + (size_t)32 * LDQ + DM); } while (0)
#define ATT_SWRITE(kbufi, vbufi) do { *(LAS v4u*)(V_lds + (vbufi) * SHM_V + vst0) = vs0; *(LAS v4u*)(V_lds + (vbufi) * SHM_V + vst1) = vs1; \
        *(LAS bf16x8*)(K_lds + (kbufi) * SHM_K + kst0) = knorm8(ks0, kg); *(LAS bf16x8*)(K_lds + (kbufi) * SHM_K + kst1) = knorm8(ks1, kg); } while (0)
    unsigned bo0[4] = {0u, 0u, 0u, 0u}, bo1[4] = {0u, 0u, 0u, 0u};
#pragma unroll
    for (int r = 0; r < 16; ++r) { const int ck0 = crow(r, hi), ck1 = 32 + ck0;
        bo0[r >> 2] |= (unsigned)(4 * (((unsigned)(ck0 - cs) < 16u) ? (ck0 - cq + 15) : 31)) << (8 * (r & 3));
        bo1[r >> 2] |= (unsigned)(4 * (((unsigned)(ck1 - cs) < 16u) ? (ck1 - cq + 15) : 31)) << (8 * (r & 3)); }
    float m_reg = -1e30f, l_reg = 0.f; f32x16 o[4];
#pragma unroll
    for (int d = 0; d < 4; ++d)
#pragma unroll
        for (int r = 0; r < 16; ++r) o[d][r] = 0.f;
    ATT_SLOAD(0); ATT_SWRITE(0, 0); __syncthreads();
    const bool upper = ATT_STAGGER && wid >= 4; bool pend = false; int pvb = 0, vbuf = 0;
    bf16x8 pa0, pa1, pa2, pa3; { const v4u z_ = {0u, 0u, 0u, 0u}; pa0 = pa1 = pa2 = pa3 = __builtin_bit_cast(bf16x8, z_); }
    for (int jt = 0; jt < ntile; ++jt) {
        const int buf = jt & 1; const int vnext = (vbuf == 2) ? 0 : vbuf + 1;
        if (jt + 1 < ntile) ATT_SLOAD(jt + 1);
        if (upper && pend) { vt_one<0>(o[0], pvb, pa0, pa1, pa2, pa3); vt_one<1>(o[1], pvb, pa0, pa1, pa2, pa3); vt_one<2>(o[2], pvb, pa0, pa1, pa2, pa3); vt_one<3>(o[3], pvb, pa0, pa1, pa2, pa3); pend = false; }
        const bool islat = jt < nlat; const int kr = klo + jt;
        const bool active = !islat || (kr >= r0q && kr <= r0q + 7);
        if (active) {
            f32x16 p0, p1;
            if (islat) { const LAS unsigned char* trow = (const LAS unsigned char*)(TAB + (kr - rq + 7) * 32);
                asm volatile("" : "+v"(bo0[0]), "+v"(bo0[1]), "+v"(bo0[2]), "+v"(bo0[3]), "+v"(bo1[0]), "+v"(bo1[1]), "+v"(bo1[2]), "+v"(bo1[3]));
#pragma unroll
                for (int r = 0; r < 16; ++r) { p0[r] = *(const LAS float*)(trow + ((bo0[r >> 2] >> (8 * (r & 3))) & 0xffu)); p1[r] = *(const LAS float*)(trow + ((bo1[r >> 2] >> (8 * (r & 3))) & 0xffu)); } }
            else {
#pragma unroll
                for (int r = 0; r < 16; ++r) { p0[r] = 0.f; p1[r] = 0.f; } }
            LDS_WAIT();
            qkt_acc(p0, p1, K_lds + buf * SHM_K, qr, r32, hi);
            float pmax = p0[0];
#pragma unroll
            for (int r = 1; r < 16; ++r) pmax = fmaxf(pmax, p0[r]);
#pragma unroll
            for (int r = 0; r < 16; ++r) pmax = fmaxf(pmax, p1[r]);
#if ATT_PERM
            { unsigned pa_ = __builtin_bit_cast(unsigned, pmax), pb_ = pa_; swap32(pa_, pb_);
              pmax = fmaxf(__builtin_bit_cast(float, pa_), __builtin_bit_cast(float, pb_)); }
#else
            pmax = fmaxf(pmax, __shfl_xor(pmax, 32));
#endif
            float mn = m_reg, alpha = 1.f;
            if (!__all(pmax - m_reg <= 8.0f)) { mn = fmaxf(m_reg, pmax); alpha = __builtin_amdgcn_exp2f(m_reg - mn); m_reg = mn; }
            float ps = 0.f;
#pragma unroll
            for (int r = 0; r < 16; ++r) { p0[r] = __builtin_amdgcn_exp2f(p0[r] - mn); p1[r] = __builtin_amdgcn_exp2f(p1[r] - mn); ps += p0[r] + p1[r]; }
#if ATT_PERM
            { unsigned pa_ = __builtin_bit_cast(unsigned, ps), pb_ = pa_; swap32(pa_, pb_);
              ps = __builtin_bit_cast(float, pa_) + __builtin_bit_cast(float, pb_); }
#else
            ps += __shfl_xor(ps, 32);
#endif
            l_reg = l_reg * alpha + ps;
            if (__any(alpha < 1.f)) {
#pragma unroll
                for (int d = 0; d < 4; ++d)
#pragma unroll
                    for (int r = 0; r < 16; ++r) o[d][r] *= alpha; }
#define ATT_PK4(P, BASE, OUT) do { const unsigned a0 = cvtpk(P[BASE + 0], P[BASE + 1]), a1 = cvtpk(P[BASE + 2], P[BASE + 3]); \
        const unsigned b0 = cvtpk(P[BASE + 4], P[BASE + 5]), b1 = cvtpk(P[BASE + 6], P[BASE + 7]); \
        auto r0_ = __builtin_amdgcn_permlane32_swap(a0, b0, false, false); auto r1_ = __builtin_amdgcn_permlane32_swap(a1, b1, false, false); \
        v4u w_ = {r0_[0], r1_[0], r0_[1], r1_[1]}; OUT = __builtin_bit_cast(bf16x8, w_); } while (0)
            ATT_PK4(p0, 0, pa0); ATT_PK4(p0, 8, pa1); ATT_PK4(p1, 0, pa2); ATT_PK4(p1, 8, pa3);
            const int vb = vb0 + vbuf * SHM_V;
            if (!upper) { vt_one<0>(o[0], vb, pa0, pa1, pa2, pa3); vt_one<1>(o[1], vb, pa0, pa1, pa2, pa3); vt_one<2>(o[2], vb, pa0, pa1, pa2, pa3); vt_one<3>(o[3], vb, pa0, pa1, pa2, pa3); }
            else { pend = true; pvb = vb; }
        }
        if (jt + 1 < ntile) ATT_SWRITE(buf ^ 1, vnext);
        vbuf = vnext;
        __syncthreads();
    }
    if (upper && pend) { vt_one<0>(o[0], pvb, pa0, pa1, pa2, pa3); vt_one<1>(o[1], pvb, pa0, pa1, pa2, pa3); vt_one<2>(o[2], pvb, pa0, pa1, pa2, pa3); vt_one<3>(o[3], pvb, pa0, pa1, pa2, pa3); }
    { const float rl = __builtin_amdgcn_rcpf(l_reg);
      GAS bf16* Ow = (GAS bf16*)AO + (size_t)(qrow0 + r32) * DM + h * HD + 8 * hi;
#pragma unroll
      for (int d0 = 0; d0 < 4; ++d0)
#pragma unroll
          for (int gp = 0; gp < 2; ++gp) { float lo4[4], hi4[4];
#pragma unroll
              for (int e = 0; e < 4; ++e) { unsigned a_ = __builtin_bit_cast(unsigned, o[d0][8 * gp + e] * rl), b_ = __builtin_bit_cast(unsigned, o[d0][8 * gp + 4 + e] * rl); swap32(a_, b_);
                  lo4[e] = __builtin_bit_cast(float, a_); hi4[e] = __builtin_bit_cast(float, b_); }
              v4u w; w.x = cvtpk(lo4[0], lo4[1]); w.y = cvtpk(lo4[2], lo4[3]); w.z = cvtpk(hi4[0], hi4[1]); w.w = cvtpk(hi4[2], hi4[3]);
              *(GAS v4u*)(Ow + d0 * 32 + gp * 16) = w; } }
    __syncthreads();
#undef ATT_KROW
#undef ATT_SLOAD
#undef ATT_SWRITE
#undef ATT_PK4
}
#undef PKLH
}

namespace sgm {
__device__ __forceinline__ void mix_unit(int n, int g, const bf16* U, const bf16* V, bf16* T, const float* ssp, const float* ws, const float* bs, const float* vgain, LAS unsigned char* lds, int tid, int wid, int lane) {
    using namespace att;
    const int r32 = lane & 31, hi = lane >> 5;
    LAS float* RST = (LAS float*)(lds + 131072);
    const int row0 = n * 128, colg = g * 512;
    if (tid < 128) { const GAS f32x4* sp = (const GAS f32x4*)((const GAS float*)ssp + (size_t)(row0 + tid) * 64); f32x4 s = sp[0];
#pragma unroll
        for (int j = 1; j < 16; ++j) s += sp[j];
        RST[tid] = 1.0f / sqrtf(((s.x + s.y) + (s.z + s.w)) * (1.0f / DM) + EPS); }
    { const int sr = tid >> 4, sc8 = (tid & 15) * 8, vst0 = v_st(sr, sc8), vst1 = v_st(32 + sr, sc8);
      v4u a[8], bq[8];
#pragma unroll
      for (int im = 0; im < 8; ++im) { const int kt = im >> 2, ct = im & 3; const GAS bf16* vp = (const GAS bf16*)V + (size_t)(row0 + kt * 64 + sr) * DM + colg + ct * 128 + sc8;
          a[im] = *(const GAS v4u*)vp; bq[im] = *(const GAS v4u*)(vp + (size_t)32 * DM); }
#pragma unroll
      for (int im = 0; im < 8; ++im) { *(LAS v4u*)(lds + im * SHM_V + vst0) = a[im]; *(LAS v4u*)(lds + im * SHM_V + vst1) = bq[im]; } }
    __syncthreads();
    const int pb = wid & 3, ch = wid >> 2;
    bf16x8 pa[8];
    { const GAS float* wp = (const GAS float*)ws + ((size_t)g * 128 + pb * 32 + r32) * 128 + hi * 8;
#pragma unroll
      for (int ks = 0; ks < 8; ++ks) { const f32x4 w0 = *(const GAS f32x4*)(wp + ks * 16), w1 = *(const GAS f32x4*)(wp + ks * 16 + 4); const LAS float* rs = RST + ks * 16 + hi * 8;
          v4u w; w.x = cvtpk(w0.x * rs[0], w0.y * rs[1]); w.y = cvtpk(w0.z * rs[2], w0.w * rs[3]); w.z = cvtpk(w1.x * rs[4], w1.y * rs[5]); w.w = cvtpk(w1.z * rs[6], w1.w * rs[7]);
          pa[ks] = __builtin_bit_cast(bf16x8, w); } }
    const float bsv = ((const GAS float*)bs)[g * 128 + pb * 32 + r32];
    const int vbl = (int)(uintptr_t)lds + v_rd_base(lane);
#pragma unroll
    for (int cc = 0; cc < 2; ++cc) { const int ct = 2 * ch + cc;
        f32x16 acc[4];
#pragma unroll
        for (int d = 0; d < 4; ++d)
#pragma unroll
            for (int r = 0; r < 16; ++r) acc[d][r] = 0.f;
#pragma unroll
        for (int kt = 0; kt < 2; ++kt) { const int vb = vbl + (kt * 4 + ct) * SHM_V;
            vt_one<0>(acc[0], vb, pa[kt * 4 + 0], pa[kt * 4 + 1], pa[kt * 4 + 2], pa[kt * 4 + 3]); vt_one<1>(acc[1], vb, pa[kt * 4 + 0], pa[kt * 4 + 1], pa[kt * 4 + 2], pa[kt * 4 + 3]);
            vt_one<2>(acc[2], vb, pa[kt * 4 + 0], pa[kt * 4 + 1], pa[kt * 4 + 2], pa[kt * 4 + 3]); vt_one<3>(acc[3], vb, pa[kt * 4 + 0], pa[kt * 4 + 1], pa[kt * 4 + 2], pa[kt * 4 + 3]); }
        const size_t rowb = (size_t)(row0 + pb * 32 + r32) * DM; const int colb = colg + ct * 128 + 8 * hi, colp = colg + ct * 128 + 4 * hi;
#pragma unroll
        for (int d0 = 0; d0 < 4; ++d0)
#pragma unroll
            for (int gp = 0; gp < 2; ++gp) {
                const f32x4 va = *(const GAS f32x4*)((const GAS float*)vgain + colp + d0 * 32 + gp * 16), vb_ = *(const GAS f32x4*)((const GAS float*)vgain + colp + d0 * 32 + gp * 16 + 8);
                float lo4[4], hi4[4];
#pragma unroll
                for (int e = 0; e < 4; ++e) { unsigned a_ = __builtin_bit_cast(unsigned, va[e] * acc[d0][8 * gp + e]), b_ = __builtin_bit_cast(unsigned, vb_[e] * acc[d0][8 * gp + 4 + e]); swap32(a_, b_);
                    lo4[e] = __builtin_bit_cast(float, a_); hi4[e] = __builtin_bit_cast(float, b_); }
                const int col = colb + d0 * 32 + gp * 16;
                const v4u uu = *(const GAS v4u*)((const GAS bf16*)U + rowb + col);
                v4u o; o.x = cvtpk(bf_lo(uu.x) * (lo4[0] + bsv), bf_hi(uu.x) * (lo4[1] + bsv)); o.y = cvtpk(bf_lo(uu.y) * (lo4[2] + bsv), bf_hi(uu.y) * (lo4[3] + bsv));
                o.z = cvtpk(bf_lo(uu.z) * (hi4[0] + bsv), bf_hi(uu.z) * (hi4[1] + bsv)); o.w = cvtpk(bf_lo(uu.w) * (hi4[2] + bsv), bf_hi(uu.w) * (hi4[3] + bsv));
                *(GAS v4u*)((GAS bf16*)T + rowb + col) = o; }
    }
    __syncthreads();
}
}

#ifndef MK_PER_PHASE
#define MK_PER_PHASE 0
#endif
constexpr int N_PHASES = 22;
#ifndef FUSE_MOD
#define FUSE_MOD 0
#endif
#ifndef XGTEST
#define XGTEST 0
#endif
#ifndef MOD_WAVES
#define MOD_WAVES 8
#endif
#ifndef CVT_WAVES
#define CVT_WAVES 4
#endif
static_assert(CVT_WAVES <= 7 && MK_PER_PHASE == 0 || !FUSE_MOD, "conversion scratch: 17920 B per wave inside the 132 KiB ring");
#ifndef PROBE_ORDER
#define PROBE_ORDER StaticOrder
#endif
#ifndef PROBE_PHASE
#define PROBE_PHASE -1
#endif
struct Args {
    const float *x, *c, *ctx, *cctx, *wada, *bada, *normg, *fwin, *fwout, *wqkv, *wo, *qgain, *kgain, *rpb, *sgwin, *sgbin, *sgvgain, *sgws, *sgbs, *sgwout;
    float* out; unsigned char* ws; int ph_lo, ph_hi;
};
__global__ void __launch_bounds__(NWAVES * 64, 2) fwd_kernel(Args args) {
    extern __shared__ __attribute__((aligned(16))) unsigned char lds_raw[];
    LAS unsigned char* lds = (LAS unsigned char*)lds_raw;
    volatile LAS unsigned* MISC = (volatile LAS unsigned*)(lds + MISC_OFF);
    const int wave = __builtin_amdgcn_readfirstlane(threadIdx.x >> 6);
    const int G = gridDim.x, bx = blockIdx.x;
#define LANE_TID() const int lane = lane_now(); const int tid = wave * 64 + lane; (void)tid
    const int vcu = (G % 8 == 0) ? (bx % 8) * (G / 8) + bx / 8 : bx;
    const int gw = vcu * NWAVES + wave, NGW = G * NWAVES;
    const int mgw = vcu * MOD_WAVES + wave, mNGW = G * MOD_WAVES;
    unsigned char* ws = args.ws;
    unsigned* ctl = (unsigned*)(ws + WS_CTL);
    float* MOD = (float*)(ws + WS_MOD); float* SSP = (float*)(ws + WS_SSP); float* PART = (float*)(ws + WS_PART);
    bf16* WIN = (bf16*)(ws + WS_WIN); bf16* WOUT = (bf16*)(ws + WS_WOUT); bf16* WQKV = (bf16*)(ws + WS_WQKV); bf16* WO = (bf16*)(ws + WS_WO);
    bf16* SGIN = (bf16*)(ws + WS_SGIN); bf16* SGOUT = (bf16*)(ws + WS_SGOUT);
    bf16* H = (bf16*)(ws + WS_H); bf16* ACT = (bf16*)(ws + WS_ACT); bf16* QKV = (bf16*)(ws + WS_QKV); bf16* AO = (bf16*)(ws + WS_AO);
    float* SWP = (float*)(ws + WS_SWP); float* SW = (float*)(ws + WS_SW); (void)SW;
    float* XSX = (float*)(ws + WS_XS); float* XSZ = XSX + (size_t)MX * DM;
        bf16* UB = (bf16*)(ws + WS_U); bf16* VB = (bf16*)(ws + WS_V); bf16* TB = (bf16*)(ws + WS_T);
    { LANE_TID(); for (int u = tid; u < (LDS_BYTES - MISC_OFF) / 4; u += NWAVES * 64) ((LAS unsigned*)(lds + MISC_OFF))[u] = 0u; }
    __syncthreads();
    XcdBarrier bar; bar.bar = ctl + CW_BAR; bar.x = 0; bar.st = nullptr;
    if (!MK_PER_PHASE) bar = xcd_barrier_post(ctl + CW_BAR, MISC + 8);
    const int lo = args.ph_lo, hi = args.ph_hi;
#define IN(k) (lo <= (k) && (k) < hi)
#define SEAM(k) do { if (!MK_PER_PHASE && IN(k) && IN((k) + 1)) xcd_barrier(bar); } while (0)
#define GEMM_PHASE(EpiT, Aptr, Bptr, Mv, Nv, Kv, ...) do { pg8::Gemm g_{(const pg8::bf16_t*)(Aptr), (const pg8::bf16_t*)(Bptr), (Mv), (Nv), (Kv), (Kv)}; pg8::StaticOrder S_; S_.init((Mv), (Nv), G, bx); \
        pg8::EpiT E_{__VA_ARGS__}; { LANE_TID(); pg8::gemm_phase<pg8::EpiT, pg8::StaticOrder, GK_ALIGN, GK_SP2>(lds, g_, S_, E_, tid); } } while (0)
#define RESID_PHASE(Aptr, Bptr, Kv, RIN, OUT, O_MODv, GSLOTv, GS2v, NGIDX, O_NMODv, NSLOTv, HASXG) do { typedef pg8::EpiResid<WS_XS, (O_MODv), WS_XB, WS_SSQ, (GSLOTv), (GS2v), WS_NG + (size_t)(NGIDX) * DM * 4, (O_NMODv), (NSLOTv), (HASXG)> Epi_; \
        pg8::Gemm g_{(const pg8::bf16_t*)(Aptr), (const pg8::bf16_t*)(Bptr), MX, DM, (Kv), (Kv)}; pg8::StaticOrder S_; S_.init(MX, DM, G, bx); Epi_ E_{ws, (RIN), (OUT)}; \
        { LANE_TID(); pg8::gemm_phase<Epi_, pg8::StaticOrder, GK_ALIGN, GK_SP2>(lds, g_, S_, E_, tid); } } while (0)
    constexpr size_t WS_MOD1 = WS_MOD + (size_t)5 * MODW * 4;
    const size_t WIN_SZ = (size_t)2 * DFF * DM, WOUT_SZ = (size_t)DM * DFF;

    for (int rep_ = 0; rep_ < ((PROBE_PHASE == 0) ? 2 : 1); ++rep_) { if (rep_) xcd_barrier(bar);
    if (IN(0)) { LANE_TID(); p_ada_partial(args.c, args.cctx, args.wada, PART, lds, vcu, G, tid, wave, lane); } } SEAM(0);
#define CVT_SET(NM, M0, M1, M2, M3, M4, M5, M6, RANK, NRANKS) do { const int mats_[7] = {M0, M1, M2, M3, M4, M5, M6}; int tot_ = 0; \
        _Pragma("unroll") for (int q_ = 0; q_ < (NM); ++q_) tot_ += cvt_items_of(mats_[q_]); \
        LAS float* scr_ = (LAS float*)(lds + wave * 17920); \
        for (int it_ = (RANK); it_ < tot_; it_ += (NRANKS)) { int r_ = it_, mat_ = mats_[0]; \
            _Pragma("unroll") for (int q_ = 0; q_ < (NM) - 1; ++q_) { const int n_ = cvt_items_of(mats_[q_]); if (mat_ == mats_[q_] && r_ >= n_) { r_ -= n_; mat_ = mats_[q_ + 1]; } } \
            const float* src_; bf16* dst_; int K_, N_; bool sw_ = false; const float* shv_ = nullptr; float* swp_ = nullptr; \
            if (mat_ < 4) { src_ = args.fwin + (size_t)mat_ * WIN_SZ; dst_ = WIN + (size_t)mat_ * WIN_SZ; K_ = DM; N_ = 2 * DFF; sw_ = true; \
                if (mat_ > 0) { shv_ = MOD + (size_t)(mat_ == 1 ? 0 : 5) * MODW + (size_t)(mat_ == 2 ? 0 : 6) * DM; swp_ = SWP + (size_t)64 * 5 * 3 * DM + (size_t)(mat_ - 1) * 64 * 5 * 2 * DFF; } } \
            else if (mat_ < 8) { src_ = args.fwout + (size_t)(mat_ - 4) * WOUT_SZ; dst_ = WOUT + (size_t)(mat_ - 4) * WOUT_SZ; K_ = DFF; N_ = DM; } \
            else if (mat_ == 8) { src_ = args.wqkv; dst_ = WQKV; K_ = DM; N_ = 3 * DM; shv_ = MOD + (size_t)3 * DM; swp_ = SWP; } \
            else if (mat_ == 9) { src_ = args.wo; dst_ = WO; K_ = DM; N_ = DM; } \
            else if (mat_ == 10) { src_ = args.sgwin; dst_ = SGIN; K_ = DM; N_ = 2 * DM; shv_ = MOD + (size_t)5 * MODW + (size_t)3 * DM; swp_ = SWP + (size_t)64 * 5 * 3 * DM + (size_t)3 * 64 * 5 * 2 * DFF; } \
            else { src_ = args.sgwout; dst_ = SGOUT; K_ = DM; N_ = DM; } \
            cvt_item(src_, K_, N_, dst_, sw_, scr_, r_, lane, FUSE_MOD ? shv_ : nullptr, swp_); } } while (0)
    for (int rep_ = 0; rep_ < ((PROBE_PHASE == 1) ? 2 : 1); ++rep_) { if (rep_) xcd_barrier(bar);
    if (IN(1)) { LANE_TID();
        p_mod_finalize(PART, args.bada, MOD, gw, NGW, lane); p_copy_normg(args.normg, (float*)(ws + WS_NG), gw, NGW, lane);
        if (FUSE_MOD && !MK_PER_PHASE) xcd_barrier(bar);
#if CVT_WAVES == 8
        CVT_SET(7, 0, 4, 2, 6, 10, 3, 7, gw, NGW); CVT_SET(3, 8, 9, 1, 1, 1, 1, 1, gw, NGW); CVT_SET(2, 5, 11, 11, 11, 11, 11, 11, gw, NGW);
#else
        if (wave < CVT_WAVES) { const int gw2 = vcu * CVT_WAVES + wave, ngw2 = G * CVT_WAVES;
        CVT_SET(7, 0, 4, 2, 6, 10, 3, 7, gw2, ngw2); CVT_SET(3, 8, 9, 1, 1, 1, 1, 1, gw2, ngw2); CVT_SET(2, 5, 11, 11, 11, 11, 11, 11, gw2, ngw2); }
#endif
    } } SEAM(1);
    for (int rep_ = 0; rep_ < ((PROBE_PHASE == 2) ? 2 : 1); ++rep_) { if (rep_) xcd_barrier(bar);
    if (IN(2)) { LANE_TID(); if (wave < MOD_WAVES) p_modulate(args.x, args.ctx, args.normg + 0 * DM, MOD, 0, H, MALL, mgw, mNGW, lane); if (FUSE_MOD) p_sw_reduce(SWP, SW, gw, NGW, lane); } } SEAM(2);
    for (int rep_ = 0; rep_ < ((PROBE_PHASE == 3) ? 2 : 1); ++rep_) { if (rep_) xcd_barrier(bar);
    if (IN(3)) { if (rep_ == 0) { GEMM_PHASE(EpiSwiGLU, H, WIN + 0 * WIN_SZ, MALL, 2 * DFF, DM, ACT, DFF); } else { pg8::Gemm g_{(const pg8::bf16_t*)H, (const pg8::bf16_t*)(WIN), MALL, 2 * DFF, DM, DM}; pg8::PROBE_ORDER S_; S_.init(MALL, 2 * DFF, G, bx); pg8::EpiNull E_{0}; { LANE_TID(); pg8::gemm_phase<pg8::EpiNull, pg8::PROBE_ORDER, GK_ALIGN, GK_SP2>(lds, g_, S_, E_, tid); } } } } SEAM(3);
    for (int rep_ = 0; rep_ < ((PROBE_PHASE == 4) ? 2 : 1); ++rep_) { if (rep_) xcd_barrier(bar);
    if (IN(4)) { RESID_PHASE(ACT, WOUT + 0 * WOUT_SZ, DFF, args.x, nullptr, WS_MOD, 2, 1, 1, WS_MOD, 4, XGTEST != 0);
        { pg8::Gemm g_{(const pg8::bf16_t*)ACT, (const pg8::bf16_t*)(WOUT), MALL, DM, 2048, DFF}; pg8::ZSplitOrder S_; S_.init(G, bx); pg8::EpiPart E_{(float*)(ws + WS_PARTZ)};
          { LANE_TID(); pg8::gemm_phase<pg8::EpiPart, pg8::ZSplitOrder, GK_ALIGN, GK_SP2>(lds, g_, S_, E_, tid); } } } } SEAM(4);
    for (int rep_ = 0; rep_ < ((PROBE_PHASE == 5) ? 2 : 1); ++rep_) { if (rep_) xcd_barrier(bar);
    if (IN(5)) { LANE_TID(); if (wave < MOD_WAVES) p_modulate_l0(XSX, args.ctx, (const float*)(ws + WS_PARTZ), args.normg + 1 * DM, MOD, 1, 2, H, mgw, mNGW, lane); } } SEAM(5);
    for (int rep_ = 0; rep_ < ((PROBE_PHASE == 6) ? 2 : 1); ++rep_) { if (rep_) xcd_barrier(bar);
    if (IN(6)) { pg8::Gemm g_{(const pg8::bf16_t*)H, (const pg8::bf16_t*)WQKV, MALL, 3 * DM, DM, DM}; pg8::QkvOrder S_; S_.init(G, bx); pg8::EpiBf16 E_{QKV, 3 * DM};
        { LANE_TID(); pg8::gemm_phase<pg8::EpiBf16, pg8::QkvOrder, GK_ALIGN, GK_SP2>(lds, g_, S_, E_, tid); } } } SEAM(6);
    for (int rep_ = 0; rep_ < ((PROBE_PHASE == 7) ? 2 : 1); ++rep_) { if (rep_) xcd_barrier(bar);
    if (IN(7)) { LANE_TID();
        for (int u = vcu; u < 1024; u += G) {
            att::attn_unit(true, u >> 8, (u >> 3) & 31, ((u & 7) + 2 * (u >> 8)) & 7, QKV, AO, args.qgain, args.kgain, args.rpb, lds, tid, wave, lane);
        }
    } } SEAM(7);
    if (IN(8)) { RESID_PHASE(AO, WO, DM, nullptr, nullptr, WS_MOD, 5, 2, 2, WS_MOD, 7, XGTEST != 0); } SEAM(8);
    if (IN(9)) { LANE_TID(); if (wave < MOD_WAVES) p_modulate(XSX, XSZ, args.normg + 2 * DM, MOD, 2, H, MX, mgw, mNGW, lane); } SEAM(9);
    if (IN(10)) { GEMM_PHASE(EpiSwiGLU, H, WIN + 1 * WIN_SZ, MX, 2 * DFF, DM, ACT, DFF); } SEAM(10);
    if (IN(11)) { RESID_PHASE(ACT, WOUT + 1 * WOUT_SZ, DFF, nullptr, nullptr, WS_MOD, 8, 1, 3, WS_MOD1, 1, XGTEST != 0); } SEAM(11);
    const float* MOD1 = MOD + 5 * MODW;
    for (int rep_ = 0; rep_ < ((PROBE_PHASE == 12) ? 2 : 1); ++rep_) { if (rep_) xcd_barrier(bar);
    if (IN(12)) { LANE_TID(); if (wave < MOD_WAVES) p_modulate(XSX, XSZ, args.normg + 3 * DM, MOD1, 0, H, MX, mgw, mNGW, lane); } } SEAM(12);
    for (int rep_ = 0; rep_ < ((PROBE_PHASE == 13) ? 2 : 1); ++rep_) { if (rep_) xcd_barrier(bar);
    if (IN(13)) { GEMM_PHASE(EpiSwiGLU, H, WIN + 2 * WIN_SZ, MX, 2 * DFF, DM, ACT, DFF); } } SEAM(13);
    if (IN(14)) { RESID_PHASE(ACT, WOUT + 2 * WOUT_SZ, DFF, nullptr, nullptr, WS_MOD1, 2, 1, 4, WS_MOD1, 4, XGTEST != 0); } SEAM(14);
    for (int rep_ = 0; rep_ < ((PROBE_PHASE == 15) ? 2 : 1); ++rep_) { if (rep_) xcd_barrier(bar);
    if (IN(15)) { LANE_TID(); if (wave < MOD_WAVES) p_modulate(XSX, XSZ, args.normg + 4 * DM, MOD1, 1, H, MX, mgw, mNGW, lane); } } SEAM(15);
    for (int rep_ = 0; rep_ < ((PROBE_PHASE == 16) ? 2 : 1); ++rep_) { if (rep_) xcd_barrier(bar);
    if (IN(16)) { GEMM_PHASE(EpiSG, H, SGIN, MX, 2 * DM, DM, UB, VB, args.sgbin, SSP); } } SEAM(16);
    for (int rep_ = 0; rep_ < ((PROBE_PHASE == 17) ? 2 : 1); ++rep_) { if (rep_) xcd_barrier(bar);
    if (IN(17)) { LANE_TID(); for (int u = vcu; u < 512; u += G) sgm::mix_unit(u >> 3, u & 7, UB, VB, TB, SSP, args.sgws, args.sgbs, args.sgvgain, lds, tid, wave, lane); } } SEAM(17);
    if (IN(18)) { RESID_PHASE(TB, SGOUT, DM, nullptr, nullptr, WS_MOD1, 5, 2, 5, WS_MOD1, 7, XGTEST != 0); } SEAM(18);
    if (IN(19)) { LANE_TID(); if (wave < MOD_WAVES) p_modulate(XSX, XSZ, args.normg + 5 * DM, MOD1, 2, H, MX, mgw, mNGW, lane); } SEAM(19);
    if (IN(20)) { GEMM_PHASE(EpiSwiGLU, H, WIN + 3 * WIN_SZ, MX, 2 * DFF, DM, ACT, DFF); } SEAM(20);
    if (IN(21)) { RESID_PHASE(ACT, WOUT + 3 * WOUT_SZ, DFF, nullptr, args.out, WS_MOD1, 8, 1, 0, WS_MOD1, 0, false); }
#undef IN
#undef SEAM
#undef GEMM_PHASE
#undef RESID_PHASE
#undef CVT_SET
#undef LANE_TID
}

extern "C" void kernel_launch(void* const* d_in, const int* in_sizes, int n_in, void* d_out, int out_size, void* d_ws, size_t ws_size, hipStream_t stream) {
    static int grid = 0;
    if (grid == 0) {
        if (n_in != 20 || in_sizes[0] != MX * DM || out_size != MX * DM || ws_size < WS_END) { fprintf(stderr, "kernel_launch: unexpected shapes (n_in %d, in0 %d, out %d, ws %zu)\n", n_in, n_in > 0 ? in_sizes[0] : -1, out_size, ws_size); grid = -1; return; }
        int dev = 0, cus = 0, per_cu = 0;
        if (hipGetDevice(&dev) != hipSuccess || hipDeviceGetAttribute(&cus, hipDeviceAttributeMultiprocessorCount, dev) != hipSuccess) { grid = -1; return; }
        if (hipFuncSetAttribute((const void*)fwd_kernel, hipFuncAttributeMaxDynamicSharedMemorySize, LDS_BYTES) != hipSuccess) { fprintf(stderr, "kernel_launch: hipFuncSetAttribute failed\n"); grid = -1; return; }
        if (hipOccupancyMaxActiveBlocksPerMultiprocessor(&per_cu, (const void*)fwd_kernel, NWAVES * 64, LDS_BYTES) != hipSuccess || per_cu < 1) fprintf(stderr, "kernel_launch: occupancy query reports %d\n", per_cu);
        (void)hipGetLastError();
        grid = cus;
    }
    if (grid < 0) return;
    if (hipMemsetAsync((char*)d_ws + WS_CTL, 0, CTL_ZERO_BYTES, stream) != hipSuccess) { fprintf(stderr, "kernel_launch: memset failed\n"); return; }
    Args a{};
    a.x = (const float*)d_in[0]; a.c = (const float*)d_in[1]; a.ctx = (const float*)d_in[2]; a.cctx = (const float*)d_in[3]; a.wada = (const float*)d_in[4]; a.bada = (const float*)d_in[5];
    a.normg = (const float*)d_in[6]; a.fwin = (const float*)d_in[7]; a.fwout = (const float*)d_in[8]; a.wqkv = (const float*)d_in[9]; a.wo = (const float*)d_in[10];
    a.qgain = (const float*)d_in[11]; a.kgain = (const float*)d_in[12]; a.rpb = (const float*)d_in[13]; a.sgwin = (const float*)d_in[14]; a.sgbin = (const float*)d_in[15];
    a.sgvgain = (const float*)d_in[16]; a.sgws = (const float*)d_in[17]; a.sgbs = (const float*)d_in[18]; a.sgwout = (const float*)d_in[19];
    a.out = (float*)d_out; a.ws = (unsigned char*)d_ws;
#if MK_PER_PHASE
    for (int p = 0; p < N_PHASES; ++p) { a.ph_lo = p; a.ph_hi = p + 1; hipLaunchKernelGGL(fwd_kernel, dim3(grid), dim3(NWAVES * 64), LDS_BYTES, stream, a); }
#else
    a.ph_lo = 0; a.ph_hi = N_PHASES; hipLaunchKernelGGL(fwd_kernel, dim3(grid), dim3(NWAVES * 64), LDS_BYTES, stream, a);
#endif
    const hipError_t le = hipPeekAtLastError();
    if (le != hipSuccess) fprintf(stderr, "kernel_launch: launch failed: %s\n", hipGetErrorName(le));
}
```

```cpp
#include <hip/hip_runtime.h>
#include <cstdio>
#include <cstdint>
#ifndef PG8_WGM
#define PG8_WGM 8
#endif
#ifndef GK_ALIGN
#define GK_ALIGN true
#endif
#ifndef PG8_FRESH
#define PG8_FRESH 0
#endif
#ifndef GK_SP2
#define GK_SP2 true
#endif
namespace pg8 {
#define PG8_LAS __attribute__((address_space(3)))
typedef unsigned short bf16_t;
typedef short bf16x8 __attribute__((ext_vector_type(8)));
typedef float f32x4 __attribute__((ext_vector_type(4)));
typedef unsigned u32x4 __attribute__((ext_vector_type(4)));
constexpr int BM = 256, BK = 64, HALF = 128, HTB = HALF * BK * 2  , STAGE_BYTES = 8 * HTB, NXCD = 8, WGM = PG8_WGM;

__host__ __device__ __forceinline__ int lds_byte(int r, int c) { const int st = (r >> 4) * 2 + (c >> 5), rr = r & 15, cc = c & 31, ob = rr * 64 + cc * 2; return st * 1024 + (ob ^ (((ob >> 9) & 1) << 5)); }
__host__ __device__ __forceinline__ void stage_rc(int b, int& R, int& C) { const int st = b / 1024, sb = b % 1024, swz = sb ^ (((sb >> 9) & 1) << 5); R = (st >> 1) * 16 + swz / 64; C = (st & 1) * 32 + (swz % 64) / 2; }
__host__ __device__ __forceinline__ int perm32(int rho) { const int n = rho >> 4, i = rho & 15; return 8 * (i >> 2) + 4 * n + (i & 3); }

struct Unit { int pm, pn, ko; };
struct Gemm { const bf16_t* A; const bf16_t* Bt; int M, N, K, ld; };

struct StaticOrder {
    int nM, nN, nwg, G, c;
    __host__ __device__ void init(int M, int N, int G_, int c_) { nM = M / BM; nN = N / BM; nwg = nM * nN; G = G_; c = c_; }
    __host__ __device__ bool next(int i, Unit& u) const {
        const long L = (long)i * G + c; if (L >= nwg) return false;
        int wgid = (int)L; { const int q = nwg / NXCD, r = nwg % NXCD, xcd = wgid % NXCD, off = wgid / NXCD; wgid = (xcd < r ? xcd * (q + 1) : r * (q + 1) + (xcd - r) * q) + off; }
        const int nig = WGM * nN, gid = wgid / nig, fm = gid * WGM, gsz = (nM - fm) < WGM ? (nM - fm) : WGM;
        u.pm = fm + ((wgid % nig) % gsz); u.pn = (wgid % nig) / gsz; u.ko = 0; return true;
    }
    __device__ __forceinline__ void a_ready(const Unit&) const {}
    __device__ __forceinline__ void done(const Unit&) const {}
};
struct QkvOrder {
    StaticOrder base; int nx;
    __host__ __device__ void init(int G_, int c_) { base.init(8192, 12288, G_, c_); nx = base.nwg; }
    __host__ __device__ bool next(int i, Unit& u) const {
        const long L = (long)i * base.G + base.c; if (L < nx) return base.next(i, u);
        const int l2 = (int)(L - nx); if (l2 >= 128) return false; u.pm = 32 + (l2 & 3); u.pn = 16 + (l2 >> 2); u.ko = 0; return true;
    }
    __device__ __forceinline__ void a_ready(const Unit&) const {}
    __device__ __forceinline__ void done(const Unit&) const {}
};
struct SameTileOrder {
    StaticOrder base;
    __host__ __device__ void init(int M, int N, int G_, int c_) { base.init(M, N, G_, c_); }
    __host__ __device__ bool next(int i, Unit& u) const { const bool ok = base.next(i, u); u.pm = 0; u.pn = 0; return ok; }
    __device__ __forceinline__ void a_ready(const Unit&) const {}
    __device__ __forceinline__ void done(const Unit&) const {}
};
struct ZSplitOrder {
    int G, c;
    __host__ __device__ void init(int G_, int c_) { G = G_; c = c_; }
    __host__ __device__ bool next(int i, Unit& u) const { const int s = i * G + c; if (s >= 256) return false; u.pm = 32 + ((s >> 2) & 3); u.pn = s >> 4; u.ko = (s & 3) * 2048 * 2; return true; }
    __device__ __forceinline__ void a_ready(const Unit&) const {}
    __device__ __forceinline__ void done(const Unit&) const {}
};

__device__ __forceinline__ unsigned cvt_pk_bf16(float lo, float hi) { unsigned r; asm volatile("v_cvt_pk_bf16_f32 %0, %1, %2" : "=v"(r) : "v"(lo), "v"(hi)); return r; }
__device__ __forceinline__ int lane_fresh() { int l; asm volatile("v_mbcnt_lo_u32_b32 %0, -1, 0\n\tv_mbcnt_hi_u32_b32 %0, -1, %0" : "=v"(l)); return l; }
typedef float f32x2 __attribute__((ext_vector_type(2)));
typedef unsigned u32x2 __attribute__((ext_vector_type(2)));
#define PG8_GAS __attribute__((address_space(1)))
#ifndef PROBE_EPI2
#define PROBE_EPI2 false
#endif

struct EpiBf16 {
    static constexpr bool PERM = true, AFTER_DRAIN = false, TWICE = false;
    bf16_t* O; int ldc;
    __device__ __forceinline__ void operator()(const f32x4 (&acc)[2][2][4][2], const Unit& u, int wr, int wc, int fr, int fq) const {
        const int row0 = u.pm * BM + wr * 64 + fr, col0 = u.pn * BM + wc * 32 + 8 * fq;
#pragma unroll
        for (int ai = 0; ai < 2; ++ai)
#pragma unroll
            for (int m = 0; m < 4; ++m) { bf16_t* rowp = O + (size_t)(row0 + ai * HALF + m * 16) * ldc + col0;
#pragma unroll
                for (int bj = 0; bj < 2; ++bj) { const f32x4 v0 = acc[ai][bj][m][0], v1 = acc[ai][bj][m][1];
                    u32x4 w; w.x = cvt_pk_bf16(v0[0], v0[1]); w.y = cvt_pk_bf16(v0[2], v0[3]); w.z = cvt_pk_bf16(v1[0], v1[1]); w.w = cvt_pk_bf16(v1[2], v1[3]);
                    *(PG8_GAS u32x4*)(rowp + bj * HALF) = w; } }
    }
};

__device__ __forceinline__ float silu_mul(float a, float g) { const float e = __builtin_amdgcn_exp2f(a * -1.4426950408889634f); return a * g * __builtin_amdgcn_rcpf(1.0f + e); }
struct EpiSwiGLU {
    static constexpr bool PERM = true, AFTER_DRAIN = false, TWICE = PROBE_EPI2;
    bf16_t* O; int ldc;
    __device__ __forceinline__ void operator()(const f32x4 (&acc)[2][2][4][2], const Unit& u, int wr, int wc, int fr, int fq) const {
        const int row0 = u.pm * BM + wr * 64 + fr, col0 = u.pn * HALF + wc * 32 + 8 * fq;
#pragma unroll
        for (int ai = 0; ai < 2; ++ai)
#pragma unroll
            for (int m = 0; m < 4; ++m) { bf16_t* rowp = O + (size_t)(row0 + ai * HALF + m * 16) * ldc + col0;
                const f32x4 a0 = acc[ai][0][m][0], a1 = acc[ai][0][m][1], g0 = acc[ai][1][m][0], g1 = acc[ai][1][m][1];
                u32x4 w; w.x = cvt_pk_bf16(silu_mul(a0[0], g0[0]), silu_mul(a0[1], g0[1])); w.y = cvt_pk_bf16(silu_mul(a0[2], g0[2]), silu_mul(a0[3], g0[3]));
                w.z = cvt_pk_bf16(silu_mul(a1[0], g1[0]), silu_mul(a1[1], g1[1])); w.w = cvt_pk_bf16(silu_mul(a1[2], g1[2]), silu_mul(a1[3], g1[3]));
                *(PG8_GAS u32x4*)rowp = w; }
    }
};

template <size_t O_XS, size_t O_MOD, size_t O_XG, size_t O_SSQ, int GSLOT, int GS2, size_t O_NG, size_t O_NMOD, int NSLOT, bool HAS_XG>
struct EpiResid {
    static constexpr bool PERM = true, AFTER_DRAIN = false, TWICE = false;
    unsigned char* ws;
    const float* rin; float* out;
    __device__ __forceinline__ void operator()(const f32x4 (&acc)[2][2][4][2], const Unit& u, int wr, int wc, int fr, int fq) const {
        unsigned long long w_ = (unsigned long long)ws; asm volatile("" : "+s"(w_));
        unsigned char* wsp = (unsigned char*)w_;
        float* xsx = (float*)(wsp + O_XS);
        const int bidx = u.pm >> 3;
        const int lrow0 = u.pm * BM + wr * 64 + fr, col0 = u.pn * BM + wc * 32 + 8 * fq, grow0 = u.pm * BM + wr * 64 + fr;
        const PG8_GAS float* ri = (const PG8_GAS float*)(rin ? rin : xsx); PG8_GAS float* ro = (PG8_GAS float*)(out ? out : xsx);
        const PG8_GAS float* gp = (const PG8_GAS float*)(wsp + O_MOD) + (size_t)bidx * 36864 + GSLOT * 4096 + col0;
        PG8_GAS bf16_t* xg = (PG8_GAS bf16_t*)(wsp + O_XG); PG8_GAS float* ssq = (PG8_GAS float*)(wsp + O_SSQ);
        f32x4 gv[2][2], nm[2][2], cur[2][2], nxt[2][2];
#pragma unroll
        for (int bj = 0; bj < 2; ++bj)
#pragma unroll
            for (int n = 0; n < 2; ++n) { gv[bj][n] = *(const PG8_GAS f32x4*)(gp + bj * HALF + n * 4) * (0.5f * GS2); cur[bj][n] = *(const PG8_GAS f32x4*)(ri + (size_t)lrow0 * 4096 + col0 + bj * HALF + n * 4);
                nm[bj][n] = (f32x4){0.f, 0.f, 0.f, 0.f};
                if (HAS_XG) { const f32x4 g_ = *(const PG8_GAS f32x4*)((const PG8_GAS float*)(wsp + O_NG) + col0 + bj * HALF + n * 4);
                    const f32x4 s_ = *(const PG8_GAS f32x4*)((const PG8_GAS float*)(wsp + O_NMOD) + (size_t)bidx * 36864 + NSLOT * 4096 + col0 + bj * HALF + n * 4); nm[bj][n] = g_ * (s_ + 1.0f); } }
#pragma unroll
        for (int g = 0; g < 8; ++g) { const int ai = g >> 2, m = g & 3; const size_t off = (size_t)(lrow0 + ai * HALF + m * 16) * 4096 + col0, goff = (size_t)(grow0 + ai * HALF + m * 16) * 4096 + col0; float ss = 0.f;
            if (g < 7) { const size_t offn = (size_t)(lrow0 + ((g + 1) >> 2) * HALF + ((g + 1) & 3) * 16) * 4096 + col0;
#pragma unroll
                for (int bj = 0; bj < 2; ++bj)
#pragma unroll
                    for (int n = 0; n < 2; ++n) nxt[bj][n] = *(const PG8_GAS f32x4*)(ri + offn + bj * HALF + n * 4); }
#pragma unroll
            for (int bj = 0; bj < 2; ++bj) { const f32x4 y0 = cur[bj][0] + gv[bj][0] * acc[ai][bj][m][0], y1 = cur[bj][1] + gv[bj][1] * acc[ai][bj][m][1];
                *(PG8_GAS f32x4*)(ro + off + bj * HALF) = y0; *(PG8_GAS f32x4*)(ro + off + bj * HALF + 4) = y1;
                if (HAS_XG) { ss += ((y0[0] * y0[0] + y0[1] * y0[1]) + (y0[2] * y0[2] + y0[3] * y0[3])) + ((y1[0] * y1[0] + y1[1] * y1[1]) + (y1[2] * y1[2] + y1[3] * y1[3]));
                    const f32x4 z0 = y0 * nm[bj][0], z1 = y1 * nm[bj][1]; u32x4 w; w.x = cvt_pk_bf16(z0[0], z0[1]); w.y = cvt_pk_bf16(z0[2], z0[3]); w.z = cvt_pk_bf16(z1[0], z1[1]); w.w = cvt_pk_bf16(z1[2], z1[3]);
                    *(PG8_GAS u32x4*)(xg + goff + bj * HALF) = w; } }
            if (HAS_XG) { ss += __shfl_xor(ss, 16); ss += __shfl_xor(ss, 32);
                if (fq == 0) ssq[(size_t)(grow0 + ai * HALF + m * 16) * 64 + u.pn * 4 + wc] = ss; }
            asm volatile("" ::: "memory");
#pragma unroll
            for (int bj = 0; bj < 2; ++bj)
#pragma unroll
                for (int n = 0; n < 2; ++n) cur[bj][n] = nxt[bj][n]; }
    }
};

struct EpiPart {
    static constexpr bool PERM = false, AFTER_DRAIN = false, TWICE = false;
    float* P;
    __device__ __forceinline__ void operator()(const f32x4 (&acc)[2][2][4][2], const Unit& u, int wr, int wc, int fr, int fq) const {
        const int lrow0 = (u.pm - 32) * BM + wr * 64 + fr, col0 = u.pn * BM + wc * 32 + 4 * fq;
        PG8_GAS float* po = (PG8_GAS float*)P + (size_t)(u.ko >> 12) * 1024 * 4096;
#pragma unroll
        for (int ai = 0; ai < 2; ++ai)
#pragma unroll
            for (int m = 0; m < 4; ++m) { const size_t off = (size_t)(lrow0 + ai * HALF + m * 16) * 4096 + col0;
#pragma unroll
                for (int bj = 0; bj < 2; ++bj)
#pragma unroll
                    for (int n = 0; n < 2; ++n) *(PG8_GAS f32x4*)(po + off + bj * HALF + n * 16) = acc[ai][bj][m][n]; }
    }
};

__device__ __forceinline__ float gelu_tanh(float x) { const float t = x * (1.0f + 0.044715f * x * x) * -2.3022081918882205f;
    return x * __builtin_amdgcn_rcpf(1.0f + __builtin_amdgcn_exp2f(t)); }
struct EpiSG {
    static constexpr bool PERM = true, AFTER_DRAIN = false, TWICE = false;
    bf16_t* U; bf16_t* V; const float* bias; float* ssp;
    __device__ __forceinline__ void operator()(const f32x4 (&acc)[2][2][4][2], const Unit& u, int wr, int wc, int fr, int fq) const {
        const bool isv = u.pn >= 16; const int row0 = u.pm * BM + wr * 64 + fr, colt = (isv ? u.pn - 16 : u.pn) * BM, col0 = colt + wc * 32 + 8 * fq, bcol0 = u.pn * BM + wc * 32 + 8 * fq;
        bf16_t* base = isv ? V : U;
        f32x4 bv[2][2];
#pragma unroll
        for (int bj = 0; bj < 2; ++bj)
#pragma unroll
            for (int n = 0; n < 2; ++n) bv[bj][n] = *(const PG8_GAS f32x4*)((const PG8_GAS float*)bias + bcol0 + bj * HALF + 4 * n);
#pragma unroll
        for (int ai = 0; ai < 2; ++ai)
#pragma unroll
            for (int m = 0; m < 4; ++m) { bf16_t* rowp = base + (size_t)(row0 + ai * HALF + m * 16) * 4096 + col0; float ss = 0.f;
#pragma unroll
                for (int bj = 0; bj < 2; ++bj) { f32x4 v0 = acc[ai][bj][m][0] + bv[bj][0], v1 = acc[ai][bj][m][1] + bv[bj][1];
#pragma unroll
                    for (int j = 0; j < 4; ++j) { v0[j] = gelu_tanh(v0[j]); v1[j] = gelu_tanh(v1[j]); ss += v0[j] * v0[j] + v1[j] * v1[j]; }
                    u32x4 w; w.x = cvt_pk_bf16(v0[0], v0[1]); w.y = cvt_pk_bf16(v0[2], v0[3]); w.z = cvt_pk_bf16(v1[0], v1[1]); w.w = cvt_pk_bf16(v1[2], v1[3]);
                    *(PG8_GAS u32x4*)(rowp + bj * HALF) = w; }
                if (isv) { ss += __shfl_xor(ss, 16); ss += __shfl_xor(ss, 32);
                    if (fq == 0) ((PG8_GAS float*)ssp)[(size_t)(row0 + ai * HALF + m * 16) * 64 + (u.pn - 16) * 4 + wc] = ss; } }
    }
};

struct EpiNull {
    static constexpr bool PERM = true, AFTER_DRAIN = false, TWICE = false;
    int dummy;
    __device__ __forceinline__ void operator()(const f32x4 (&acc)[2][2][4][2], const Unit& u, int wr, int wc, int fr, int fq) const {
#pragma unroll
        for (int ai = 0; ai < 2; ++ai)
#pragma unroll
            for (int bj = 0; bj < 2; ++bj)
#pragma unroll
                for (int m = 0; m < 4; ++m)
#pragma unroll
                    for (int n = 0; n < 2; ++n) asm volatile("" :: "v"(acc[ai][bj][m][n]));
    }
};
template <class Epi, class Sched, bool ALIGN_EPI = false, bool SP2 = false>
__device__ __forceinline__ void gemm_phase(PG8_LAS unsigned char* lds, const Gemm g, const Sched& S, const Epi& E, const int tid) {
    const int wid = __builtin_amdgcn_readfirstlane(tid >> 6), lane = tid & 63, wr = wid >> 2, wc = wid & 3, fr = lane & 15, fq = lane >> 4;
    const int K = g.ld, nt = g.K / BK;
    unsigned voffA[2], voffB[2];
#pragma unroll
    for (int i = 0; i < 2; ++i) { int R, C; stage_rc(tid * 16 + i * 8192, R, C); const int Rb = Epi::PERM ? ((R & ~31) + perm32(R & 31)) : R;
        voffA[i] = (unsigned)(R * K + C) * 2u; voffB[i] = (unsigned)(Rb * K + C) * 2u; }
    const size_t kstep = (size_t)(BK * 2);
    const size_t hstep = (size_t)HALF * K * 2;
    const size_t tstep = 2 * hstep;
    const unsigned ldsw = (unsigned)wid * 1024u;
    const int aoff = lds_byte(wr * 64 + fr, fq * 8), boff = lds_byte(wc * 32 + fr, fq * 8);
#define PG8_SA(b, h) (((b) * 2 + (h)) * HTB)
#define PG8_SB(b, h) ((4 + (b) * 2 + (h)) * HTB)
#define PG8_STAGE(bufoff, gbase, voff) do { _Pragma("unroll") for (int _i = 0; _i < 2; ++_i) \
        __builtin_amdgcn_global_load_lds((const unsigned*)((const char*)(gbase) + (voff)[_i]), (PG8_LAS unsigned*)(lds + (bufoff) + ldsw + _i * 8192), 16, 0, 0); } while (0)
#define PG8_LDA(dst, b, h) do { _Pragma("unroll") for (int m = 0; m < 4; ++m) _Pragma("unroll") for (int k = 0; k < 2; ++k) dst[m][k] = *(const PG8_LAS bf16x8*)(lds + PG8_SA(b, h) + aoff + m * 2048 + k * 1024); } while (0)
#define PG8_LDB(dst, b, h) do { _Pragma("unroll") for (int n = 0; n < 2; ++n) _Pragma("unroll") for (int k = 0; k < 2; ++k) dst[n][k] = *(const PG8_LAS bf16x8*)(lds + PG8_SB(b, h) + boff + n * 2048 + k * 1024); } while (0)
#define PG8_MMA(ai, bj, At, Bt) do { __builtin_amdgcn_s_setprio(1); _Pragma("unroll") for (int m = 0; m < 4; ++m) _Pragma("unroll") for (int n = 0; n < 2; ++n) _Pragma("unroll") for (int k = 0; k < 2; ++k) \
        acc[ai][bj][m][n] = __builtin_amdgcn_mfma_f32_16x16x32_bf16(Bt[n][k], At[m][k], acc[ai][bj][m][n], 0, 0, 0); __builtin_amdgcn_s_setprio(0); } while (0)
#define PG8_WAIT_V(n) asm volatile("s_waitcnt vmcnt(" #n ")" ::: "memory")
#define PG8_WAIT_L(n) asm volatile("s_waitcnt lgkmcnt(" #n ")" ::: "memory")
#define PG8_BAR __builtin_amdgcn_s_barrier()
#define PG8_SCHED __builtin_amdgcn_sched_barrier(0)
    Unit cur, nxt; int ui = 0;
    if (!S.next(0, cur)) return;
    f32x4 acc[2][2][4][2];
#pragma unroll
    for (int a = 0; a < 2; ++a)
#pragma unroll
        for (int b = 0; b < 2; ++b)
#pragma unroll
            for (int m = 0; m < 4; ++m)
#pragma unroll
                for (int n = 0; n < 2; ++n) acc[a][b][m][n] = (f32x4){0.f, 0.f, 0.f, 0.f};
    bf16x8 At[4][2], B0[2][2], B1[2][2];
    const char* cA = (const char*)g.A + (size_t)cur.pm * tstep + cur.ko; const char* cB = (const char*)g.Bt + (size_t)cur.pn * tstep + cur.ko;
    S.a_ready(cur);
    if constexpr (SP2) {
        PG8_STAGE(PG8_SB(0, 0), cB, voffB); PG8_STAGE(PG8_SB(0, 1), cB + hstep, voffB); PG8_STAGE(PG8_SA(0, 0), cA, voffA); PG8_STAGE(PG8_SA(0, 1), cA + hstep, voffA);
        if (wr == 1) PG8_BAR;
        PG8_WAIT_V(2); PG8_BAR;
        PG8_STAGE(PG8_SB(1, 0), cB + kstep, voffB); PG8_STAGE(PG8_SA(1, 0), cA + kstep, voffA); PG8_STAGE(PG8_SB(1, 1), cB + hstep + kstep, voffB);
        PG8_WAIT_V(6); PG8_BAR;
    } else {
        PG8_STAGE(PG8_SB(0, 0), cB, voffB); PG8_STAGE(PG8_SA(0, 0), cA, voffA); PG8_STAGE(PG8_SB(0, 1), cB + hstep, voffB); PG8_STAGE(PG8_SA(0, 1), cA + hstep, voffA);
        if (wr == 1) PG8_BAR;
        PG8_WAIT_V(4); PG8_BAR;
        PG8_STAGE(PG8_SB(1, 0), cB + kstep, voffB); PG8_STAGE(PG8_SA(1, 0), cA + kstep, voffA); PG8_STAGE(PG8_SB(1, 1), cB + hstep + kstep, voffB);
        PG8_WAIT_V(6); PG8_BAR;
    }
    for (;;) {
        const bool has_next = S.next(ui + 1, nxt);
        const char* nA = has_next ? (const char*)g.A + (size_t)nxt.pm * tstep + nxt.ko : cA; const char* nB = has_next ? (const char*)g.Bt + (size_t)nxt.pn * tstep + nxt.ko : cB;
        for (int t = 0; t < nt; t += 2) {
            const bool last = (t == nt - 2);
            const char* a1 = cA + (size_t)(t + 1) * kstep;
            const char* a2 = last ? nA : cA + (size_t)(t + 2) * kstep; const char* b2 = last ? nB : cB + (size_t)(t + 2) * kstep;
            const char* a3 = a2 + kstep; const char* b3 = b2 + kstep;
            if (last && has_next) S.a_ready(nxt);
            if constexpr (SP2) {
            PG8_LDB(B0, 0, 0); PG8_LDB(B1, 0, 1); PG8_SCHED; PG8_LDA(At, 0, 0); PG8_STAGE(PG8_SA(1, 1), a1 + hstep, voffA);
            PG8_WAIT_V(8); PG8_WAIT_L(0); PG8_BAR; PG8_MMA(0, 0, At, B0); PG8_MMA(0, 1, At, B1); PG8_BAR; PG8_SCHED;
            PG8_LDA(At, 0, 1); PG8_STAGE(PG8_SB(0, 0), b2, voffB); PG8_STAGE(PG8_SB(0, 1), b2 + hstep, voffB); PG8_STAGE(PG8_SA(0, 0), a2, voffA);
            PG8_WAIT_V(8); PG8_WAIT_L(0); PG8_BAR; PG8_MMA(1, 0, At, B0); PG8_MMA(1, 1, At, B1); PG8_BAR; PG8_SCHED;
            PG8_LDB(B0, 1, 0); PG8_LDB(B1, 1, 1); PG8_SCHED; PG8_LDA(At, 1, 0); PG8_STAGE(PG8_SA(0, 1), a2 + hstep, voffA);
            PG8_WAIT_V(8); PG8_WAIT_L(0); PG8_BAR; PG8_MMA(0, 0, At, B0); PG8_MMA(0, 1, At, B1); PG8_BAR; PG8_SCHED;
            PG8_LDA(At, 1, 1); PG8_STAGE(PG8_SB(1, 0), b3, voffB); PG8_STAGE(PG8_SB(1, 1), b3 + hstep, voffB); PG8_STAGE(PG8_SA(1, 0), a3, voffA);
            PG8_WAIT_V(8); PG8_WAIT_L(0); PG8_BAR; PG8_MMA(1, 0, At, B0); PG8_MMA(1, 1, At, B1); PG8_BAR; PG8_SCHED;
            } else {
            PG8_LDB(B0, 0, 0); PG8_SCHED; PG8_LDA(At, 0, 0); PG8_STAGE(PG8_SA(1, 1), a1 + hstep, voffA);
            PG8_WAIT_L(8); PG8_BAR; PG8_WAIT_L(0); PG8_MMA(0, 0, At, B0); PG8_BAR; PG8_SCHED;
            PG8_LDB(B1, 0, 1); PG8_STAGE(PG8_SB(0, 0), b2, voffB);
            PG8_BAR; PG8_WAIT_L(0); PG8_MMA(0, 1, At, B1); PG8_BAR;
            PG8_LDA(At, 0, 1); PG8_STAGE(PG8_SA(0, 0), a2, voffA);
            PG8_BAR; PG8_WAIT_L(0); PG8_MMA(1, 0, At, B0); PG8_BAR; PG8_SCHED;
            PG8_STAGE(PG8_SB(0, 1), b2 + hstep, voffB);
            PG8_WAIT_V(6); PG8_BAR; PG8_MMA(1, 1, At, B1); PG8_BAR;
            PG8_LDB(B0, 1, 0); PG8_SCHED; PG8_LDA(At, 1, 0); PG8_STAGE(PG8_SA(0, 1), a2 + hstep, voffA);
            PG8_WAIT_L(8); PG8_BAR; PG8_WAIT_L(0); PG8_MMA(0, 0, At, B0); PG8_BAR; PG8_SCHED;
            PG8_LDB(B1, 1, 1); PG8_STAGE(PG8_SB(1, 0), b3, voffB);
            PG8_BAR; PG8_WAIT_L(0); PG8_MMA(0, 1, At, B1); PG8_BAR;
            PG8_LDA(At, 1, 1); PG8_STAGE(PG8_SA(1, 0), a3, voffA);
            PG8_BAR; PG8_WAIT_L(0); PG8_MMA(1, 0, At, B0); PG8_BAR; PG8_SCHED;
            PG8_STAGE(PG8_SB(1, 1), b3 + hstep, voffB);
            PG8_WAIT_V(6); PG8_BAR; PG8_MMA(1, 1, At, B1); PG8_BAR;
            }
        }
        if constexpr (ALIGN_EPI) { if (wr == 0) PG8_BAR; }
        if constexpr (!Epi::AFTER_DRAIN) { const int le_ = PG8_FRESH ? lane_fresh() : lane; E(acc, cur, wr, wc, le_ & 15, le_ >> 4);
            if constexpr (Epi::TWICE) { asm volatile("" ::: "memory"); E(acc, cur, wr, wc, le_ & 15, le_ >> 4); } S.done(cur); }
        if (!has_next) break;
#pragma unroll
        for (int a = 0; a < 2; ++a)
#pragma unroll
            for (int b = 0; b < 2; ++b)
#pragma unroll
                for (int m = 0; m < 4; ++m)
#pragma unroll
                    for (int n = 0; n < 2; ++n) acc[a][b][m][n] = (f32x4){0.f, 0.f, 0.f, 0.f};
        cur = nxt; cA = nA; cB = nB; ++ui;
        if constexpr (ALIGN_EPI) { if (wr == 1) PG8_BAR; }
    }
    PG8_WAIT_V(0);
    if constexpr (!ALIGN_EPI) { if (wr == 0) PG8_BAR; }
    PG8_BAR;
    if constexpr (Epi::AFTER_DRAIN) { E.fused(acc, cur, wr, wc, fr, fq, lds, wid, lane); S.done(cur); }
#undef PG8_SA
#undef PG8_SB
#undef PG8_STAGE
#undef PG8_LDA
#undef PG8_LDB
#undef PG8_MMA
#undef PG8_WAIT_V
#undef PG8_WAIT_L
#undef PG8_BAR
#undef PG8_SCHED
}
}

constexpr int DM = 4096, NB = 4, SEQ = 2048, CTX = 256, GW = 64, NH = 32, HD = 128, DFF = 8192, NMOD = 9;
constexpr int MX = NB * SEQ, MZ = NB * CTX, MALL = MX + MZ;
constexpr int MODW = NMOD * DM;
constexpr float EPS = 1e-6f, LOG2E = 1.4426950408889634f;
constexpr int KSPLIT = 8;

constexpr size_t MiB = 1u << 20;
constexpr size_t WS_CTL = 0, CTL_ZERO_BYTES = 32768;
constexpr size_t WS_MOD  = 2 * MiB;
constexpr size_t WS_SSP  = 4 * MiB;
constexpr size_t WS_NG   = 28 * MiB;
constexpr size_t WS_SSQ  = 29 * MiB;
constexpr size_t WS_PART = 8 * MiB;
constexpr size_t WS_WIN  = 32 * MiB;
constexpr size_t WS_WOUT = WS_WIN + 4 * 128 * MiB;
constexpr size_t WS_WQKV = WS_WOUT + 4 * 64 * MiB;
constexpr size_t WS_WO   = WS_WQKV + 96 * MiB;
constexpr size_t WS_SGIN = WS_WO + 32 * MiB;
constexpr size_t WS_SGOUT = WS_SGIN + 64 * MiB;
constexpr size_t WS_H    = WS_SGOUT + 32 * MiB;
constexpr size_t WS_ACT  = WS_H + 72 * MiB;
constexpr size_t WS_QKV  = WS_ACT + 144 * MiB;
constexpr size_t WS_AO   = WS_QKV + 216 * MiB;
constexpr size_t WS_XS   = WS_AO + 72 * MiB;
constexpr size_t WS_U    = WS_XS + 144 * MiB;
constexpr size_t WS_V    = WS_U + 64 * MiB;
constexpr size_t WS_T    = WS_V + 64 * MiB;
constexpr size_t WS_XB   = WS_T + 64 * MiB;
constexpr size_t WS_PARTZ = WS_XB + 72 * MiB;
constexpr size_t WS_SWP  = WS_PARTZ + 64 * MiB;
constexpr size_t WS_SW   = WS_SWP + 96 * MiB;
constexpr size_t WS_END  = WS_SW + 2 * MiB;
constexpr int CW_BAR = 4096;

constexpr int RING_BYTES = 135168;
constexpr int MISC_OFF = RING_BYTES;
constexpr int LDS_BYTES = 139264;
constexpr int NWAVES = 8;

#define GAS __attribute__((address_space(1)))
#define LAS __attribute__((address_space(3)))
typedef unsigned short bf16;
typedef unsigned v4u __attribute__((ext_vector_type(4)));
typedef unsigned v2u __attribute__((ext_vector_type(2)));
typedef float f32x4 __attribute__((ext_vector_type(4)));
typedef float f32x16 __attribute__((ext_vector_type(16)));
typedef short bf16x8 __attribute__((ext_vector_type(8)));
typedef short s16x4 __attribute__((ext_vector_type(4)));
#define LDS_WAIT() asm volatile("s_waitcnt lgkmcnt(0)" ::: "memory")
#define VM_WAIT() asm volatile("s_waitcnt vmcnt(0)" ::: "memory")
#define SBAR() __builtin_amdgcn_sched_barrier(0)
__device__ __forceinline__ unsigned cvtpk(float lo, float hi) { unsigned r; asm volatile("v_cvt_pk_bf16_f32 %0, %1, %2" : "=v"(r) : "v"(lo), "v"(hi)); return r; }
__device__ __forceinline__ float bf_lo(unsigned w) { return __builtin_bit_cast(float, w << 16); }
__device__ __forceinline__ float bf_hi(unsigned w) { return __builtin_bit_cast(float, w & 0xffff0000u); }
__device__ __forceinline__ float wave_sum(float v) {
#pragma unroll
    for (int o = 1; o < 64; o <<= 1) v += __shfl_xor(v, o);
    return v;
}
__device__ __forceinline__ int lane_now() { int l; asm volatile("v_mbcnt_lo_u32_b32 %0, -1, 0\n\tv_mbcnt_hi_u32_b32 %0, -1, %0" : "=v"(l)); return l; }
__device__ __forceinline__ void swap32(unsigned& a, unsigned& b) { asm volatile("s_nop 1\n\tv_permlane32_swap_b32 %0, %1" : "+v"(a), "+v"(b)); }
#define XB_TMO      128
#define XB_XCNT(j)  (256  + 64 * (j))
#define XB_XSUB(j)  (1280 + 64 * (j))
#define XB_XGEN(j)  (2304 + 64 * (j))
#define XB_TOP      3328
#define XB_TOPGEN   3392
#define XCD_BAR_WORDS 3456
#define XB_SPIN_CAP (1u << 18)

__device__ __forceinline__ unsigned xb_ld(unsigned* p)              { return __hip_atomic_load(p, __ATOMIC_RELAXED, __HIP_MEMORY_SCOPE_AGENT); }
__device__ __forceinline__ unsigned xb_add(unsigned* p, unsigned v) { return __hip_atomic_fetch_add(p, v, __ATOMIC_RELAXED, __HIP_MEMORY_SCOPE_AGENT); }
__device__ __forceinline__ unsigned xb_xcc_id() { return (unsigned)__builtin_amdgcn_s_getreg((3 << 11) | 20) & 0xFu; }
#define XB_SPIN(cond, bar) do { unsigned _sp = 0; while (cond) { __builtin_amdgcn_s_sleep(1); \
    if ((++_sp & 255u) == 0u) { if (xb_ld(&(bar)[XB_TMO])) break; if (_sp > XB_SPIN_CAP) { atomicAdd(&(bar)[XB_TMO], 1u); break; } } } } while (0)

struct XcdBarrier {
    unsigned* bar; unsigned x;
    volatile LAS unsigned* st;
};

__device__ __forceinline__ XcdBarrier xcd_barrier_post(unsigned* bar, volatile LAS unsigned* st) {
    XcdBarrier b; b.bar = bar; b.x = xb_xcc_id(); b.st = st;
    if (threadIdx.x == 0) (void)xb_add(&bar[XB_XCNT(b.x)], 1u);
    return b;
}
__device__ __forceinline__ void xcd_barrier_complete(unsigned* bar, unsigned x, unsigned& nloc, unsigned& nx) {
    const unsigned G = gridDim.x * gridDim.y * gridDim.z;
    unsigned sum, cnt, mine, sp = 0u;
    for (;;) {
        sum = 0u; cnt = 0u; mine = 0u;
#pragma unroll
        for (unsigned j = 0; j < 16; ++j) { const unsigned c = xb_ld(&bar[XB_XCNT(j)]); sum += c; cnt += (c > 0u) ? 1u : 0u; mine = (j == x) ? c : mine; }
        if (sum == G) break;
        __builtin_amdgcn_s_sleep(1);
        if ((++sp & 255u) == 0u) { if (xb_ld(&bar[XB_TMO])) break; if (sp > XB_SPIN_CAP) { atomicAdd(&bar[XB_TMO], 1u); break; } }
    }
    nloc = mine > 0u ? mine : 1u; nx = cnt > 0u ? cnt : 1u;
}

__device__ __forceinline__ void xcd_barrier(const XcdBarrier& b) {
    asm volatile("s_waitcnt vmcnt(0)" ::: "memory");
    __syncthreads();
    if (threadIdx.x == 0) {
        unsigned* bar = b.bar;
        __builtin_amdgcn_s_waitcnt(0);
        unsigned nloc = b.st[0], nx = b.st[1];
        if (nloc == 0u) { xcd_barrier_complete(bar, b.x, nloc, nx); b.st[0] = nloc; b.st[1] = nx; }
        const unsigned old = xb_add(&bar[XB_XSUB(b.x)], 1u);
        const unsigned gen = old / nloc;
        if (old + 1u == (gen + 1u) * nloc) {
            __builtin_amdgcn_fence(__ATOMIC_RELEASE, "agent");
            asm volatile("s_waitcnt vmcnt(0)" ::: "memory");
            const unsigned og = xb_add(&bar[XB_TOP], 1u);
            const unsigned tg = og / nx;
            if (og + 1u == (tg + 1u) * nx) xb_add(&bar[XB_TOPGEN], 1u);
            else XB_SPIN(xb_ld(&bar[XB_TOPGEN]) == tg, bar);
            __builtin_amdgcn_fence(__ATOMIC_ACQUIRE, "agent");
            xb_add(&bar[XB_XGEN(b.x)], 1u);
            asm volatile("s_waitcnt vmcnt(0)" ::: "memory");
        } else {
            XB_SPIN(xb_ld(&bar[XB_XGEN(b.x)]) == gen, bar);
            __builtin_amdgcn_fence(__ATOMIC_ACQUIRE, "agent");
            asm volatile("s_waitcnt vmcnt(0)" ::: "memory");
        }
    }
    __syncthreads();
}

#ifndef ADA_WAVES
#define ADA_WAVES 8
#endif
__device__ __forceinline__ void p_ada_partial(const float* c, const float* cctx, const float* wada, float* part, LAS unsigned char* lds, int vcu, int G, int tid, int wave, int lane) {
    constexpr int KW = DM / KSPLIT / ADA_WAVES;
    LAS float* sil = (LAS float*)(lds + 65536) + wave * (5 * KW);
    LAS float* red = (LAS float*)lds;
    constexpr int NITEM = 2 * (MODW / 256) * KSPLIT;
    for (int it = vcu; it < NITEM; it += G) {
        const int i = it / ((MODW / 256) * KSPLIT), rem = it % ((MODW / 256) * KSPLIT), cg = rem / KSPLIT, ks = rem % KSPLIT;
        const int k0 = ks * (DM / KSPLIT) + wave * KW;
        if (wave < ADA_WAVES) {
        const GAS float* wp = (const GAS float*)wada + ((size_t)i * DM + k0) * MODW + cg * 256 + 4 * lane;
        f32x4 wA[16], wB[16];
#pragma unroll
        for (int j = 0; j < 16; ++j) wA[j] = __builtin_nontemporal_load((const GAS f32x4*)(wp + (size_t)j * MODW));
#pragma unroll
        for (int j = 0; j < 5 * KW / 64; ++j) { const int idx = lane + 64 * j; const int r = idx / KW, kk = idx % KW;
            const float x = (r < 4) ? ((const GAS float*)c)[r * DM + k0 + kk] : ((const GAS float*)cctx)[k0 + kk];
            sil[idx] = x * __builtin_amdgcn_rcpf(1.0f + __builtin_amdgcn_exp2f(-x * LOG2E)); }
        f32x4 acc[5];
#pragma unroll
        for (int r = 0; r < 5; ++r) acc[r] = (f32x4){0.f, 0.f, 0.f, 0.f};
        LDS_WAIT();
#pragma unroll
        for (int hb = 0; hb < KW / 16; hb += 2) {
#pragma unroll
            for (int j = 0; j < 16; ++j) wB[j] = __builtin_nontemporal_load((const GAS f32x4*)(wp + (size_t)((hb + 1) * 16 + j) * MODW));
#pragma unroll
            for (int j = 0; j < 16; ++j)
#pragma unroll
                for (int r = 0; r < 5; ++r) acc[r] += wA[j] * sil[r * KW + hb * 16 + j];
            if (hb + 2 < KW / 16) {
#pragma unroll
                for (int j = 0; j < 16; ++j) wA[j] = __builtin_nontemporal_load((const GAS f32x4*)(wp + (size_t)((hb + 2) * 16 + j) * MODW)); }
#pragma unroll
            for (int j = 0; j < 16; ++j)
#pragma unroll
                for (int r = 0; r < 5; ++r) acc[r] += wB[j] * sil[r * KW + (hb + 1) * 16 + j];
        }
#pragma unroll
        for (int r = 0; r < 5; ++r) *(LAS f32x4*)(red + (wave * 5 + r) * 256 + 4 * lane) = acc[r];
        }
        __syncthreads();
        if (tid < 320) { const int r = tid >> 6, c4 = tid & 63; f32x4 s = (f32x4){0.f, 0.f, 0.f, 0.f};
#pragma unroll
            for (int w = 0; w < ADA_WAVES; ++w) s += *(LAS f32x4*)(red + (w * 5 + r) * 256 + 4 * c4);
            *(GAS f32x4*)((GAS float*)part + ((size_t)(ks * 5 + r) * 2 + i) * MODW + cg * 256 + 4 * c4) = s; }
        __syncthreads();
    }
}
__device__ __forceinline__ void p_mod_finalize(const float* part, const float* bada, float* mod, int gw, int NGW, int lane) {
    constexpr int N4 = 2 * 5 * MODW / 4;
    for (int idx = gw * 64 + lane; idx < N4; idx += NGW * 64) {
        const int e = idx * 4, i = e / (5 * MODW), r = (e / MODW) % 5, col = e % MODW;
        f32x4 s = *(const GAS f32x4*)((const GAS float*)bada + (size_t)i * MODW + col);
#pragma unroll
        for (int ks = 0; ks < KSPLIT; ++ks) s += *(const GAS f32x4*)((const GAS float*)part + ((size_t)(ks * 5 + r) * 2 + i) * MODW + col);
        *(GAS f32x4*)((GAS float*)mod + (size_t)(i * 5 + r) * MODW + col) = s;
    }
}
__device__ __forceinline__ void p_copy_normg(const float* normg, float* ng, int gw, int NGW, int lane) {
    for (int idx = gw * 64 + lane; idx < 6 * DM / 4; idx += NGW * 64) ((GAS f32x4*)ng)[idx] = ((const GAS f32x4*)normg)[idx];
}
#ifndef CVT_NTSTORE
#define CVT_NTSTORE 0
#endif
#ifndef CVT_KFAST
#define CVT_KFAST 0
#endif
__device__ __forceinline__ unsigned f2bf(float f) { unsigned u = __builtin_bit_cast(unsigned, f); return (u + 0x7fffu + ((u >> 16) & 1u)) >> 16; }
__device__ __forceinline__ unsigned pk2(float lo, float hi) { return f2bf(lo) | (f2bf(hi) << 16); }
__device__ __forceinline__ void cvt_item(const float* W, int K, int N, bf16* WT, bool swiglu, LAS float* scr, int item, int lane, const float* shiftv, float* swp) {
    #if CVT_KFAST
    const int kblk = K >> 6, nb = item / kblk, kb = item - nb * kblk, k0 = kb << 6, n0 = nb << 6;
#else
    const int nblk = N >> 6, kb = item / nblk, nb = item - kb * nblk, k0 = kb << 6, n0 = nb << 6;
#endif
    const int c4 = lane & 15, rr = lane >> 4;
    const GAS float* src = (const GAS float*)W + (size_t)(k0 + rr) * N + n0 + 4 * c4;
    f32x4 v[16];
#pragma unroll
    for (int j = 0; j < 16; ++j) v[j] = __builtin_nontemporal_load((const GAS f32x4*)(src + (size_t)(4 * j) * N));
#pragma unroll
    for (int j = 0; j < 16; ++j) { LAS float* d = scr + (4 * j + rr) * 65 + 4 * c4; d[0] = v[j].x; d[1] = v[j].y; d[2] = v[j].z; d[3] = v[j].w; }
    int vrow0 = n0;
    if (swiglu) { const int half = N >> 1; vrow0 = (n0 < half) ? (((n0 >> 7) << 8) + (n0 & 127)) : ((((n0 - half) >> 7) << 8) + 128 + ((n0 - half) & 127)); }
    if (shiftv) { LAS float* shl = scr + 64 * 65;
#pragma unroll
        for (int b = 0; b < 5; ++b) shl[b * 64 + lane] = ((const GAS float*)shiftv)[(size_t)b * MODW + k0 + lane];
        LDS_WAIT(); asm volatile("" ::: "memory");
        f32x4 sa[5];
#pragma unroll
        for (int b = 0; b < 5; ++b) { sa[b] = (f32x4){0.f, 0.f, 0.f, 0.f};
#pragma unroll
            for (int j = 0; j < 16; ++j) sa[b] += v[j] * shl[b * 64 + 4 * j + rr]; }
#pragma unroll
        for (int b = 0; b < 5; ++b) {
#pragma unroll
            for (int e = 0; e < 4; ++e) { float t = sa[b][e]; t += __shfl_xor(t, 16); t += __shfl_xor(t, 32); sa[b][e] = t; }
            if (rr == 0) *(GAS f32x4*)((GAS float*)swp + ((size_t)kb * 5 + b) * N + vrow0 + 4 * c4) = sa[b]; } }
    LDS_WAIT(); asm volatile("" ::: "memory");
    const int c8 = lane & 7;
#pragma unroll
    for (int j2 = 0; j2 < 8; ++j2) { const int n = (lane >> 3) + 8 * j2; const LAS float* s = scr + (8 * c8) * 65 + n;
        v4u o; o.x = cvtpk(s[0 * 65], s[1 * 65]); o.y = cvtpk(s[2 * 65], s[3 * 65]); o.z = cvtpk(s[4 * 65], s[5 * 65]); o.w = cvtpk(s[6 * 65], s[7 * 65]);
#if CVT_NTSTORE
        __builtin_nontemporal_store(o, (GAS v4u*)((GAS bf16*)WT + (size_t)(vrow0 + n) * K + k0 + 8 * c8)); }
#else
        *(GAS v4u*)((GAS bf16*)WT + (size_t)(vrow0 + n) * K + k0 + 8 * c8) = o; }
#endif
    LDS_WAIT(); asm volatile("" ::: "memory");
}
__device__ __forceinline__ constexpr int cvt_items_of(int mat) { return mat < 4 ? (DM / 64) * (2 * DFF / 64) : mat < 8 ? (DFF / 64) * (DM / 64) : mat == 8 ? (DM / 64) * (3 * DM / 64) : mat == 10 ? (DM / 64) * (2 * DM / 64) : (DM / 64) * (DM / 64); }
__device__ __forceinline__ void p_modulate(const float* xs_x, const float* xs_z, const float* gain, const float* modl, int j, bf16* H, int M, int gw, int NGW, int lane) {
    for (int m = gw; m < M; m += NGW) {
        const bool isx = m < MX; const int bidx = isx ? (m >> 11) : 4;
        const GAS f32x4* xr = (const GAS f32x4*)((isx ? (const GAS float*)xs_x + (size_t)m * DM : (const GAS float*)xs_z + (size_t)(m - MX) * DM)) + lane;
        const GAS f32x4* gp = (const GAS f32x4*)((const GAS float*)gain) + lane;
        const GAS f32x4* shp = (const GAS f32x4*)((const GAS float*)modl + (size_t)bidx * MODW + (3 * j) * DM) + lane;
        const GAS f32x4* scp = (const GAS f32x4*)((const GAS float*)modl + (size_t)bidx * MODW + (3 * j + 1) * DM) + lane;
        f32x4 v[16]; float s = 0.f;
#pragma unroll
        for (int q = 0; q < 16; ++q) { v[q] = xr[64 * q]; s += (v[q].x * v[q].x + v[q].y * v[q].y) + (v[q].z * v[q].z + v[q].w * v[q].w); }
        const float rstd = 1.0f / sqrtf(wave_sum(s) * (1.0f / DM) + EPS);
        GAS v2u* o8 = (GAS v2u*)((GAS bf16*)H + (size_t)m * DM) + lane;
#pragma unroll
        for (int q = 0; q < 16; ++q) { const f32x4 g = gp[64 * q], sc = scp[64 * q], sh = shp[64 * q];
            const f32x4 y = v[q] * rstd * g * (sc + 1.0f) + sh; v2u o; o.x = cvtpk(y.x, y.y); o.y = cvtpk(y.z, y.w); o8[64 * q] = o; }
    }
}
__device__ __forceinline__ void p_modulate_b(const bf16* XB, const float* ssq, const float* gain, const float* modl, int j, bf16* H, int M, int gw, int NGW, int lane) {
    for (int m = gw; m < M; m += NGW) {
        const int bidx = (m < MX) ? (m >> 11) : 4;
        const GAS v4u* xr = (const GAS v4u*)((const GAS bf16*)XB + (size_t)m * DM) + lane;
        v4u v[8];
#pragma unroll
        for (int q = 0; q < 8; ++q) v[q] = xr[64 * q];
        const float rstd = 1.0f / sqrtf(wave_sum(((const GAS float*)ssq)[(size_t)m * 64 + lane]) * (1.0f / DM) + EPS);
        const GAS f32x4* gp = (const GAS f32x4*)((const GAS float*)gain) + 2 * lane;
        const GAS f32x4* shp = (const GAS f32x4*)((const GAS float*)modl + (size_t)bidx * MODW + (3 * j) * DM) + 2 * lane;
        const GAS f32x4* scp = (const GAS f32x4*)((const GAS float*)modl + (size_t)bidx * MODW + (3 * j + 1) * DM) + 2 * lane;
        GAS v4u* o16 = (GAS v4u*)((GAS bf16*)H + (size_t)m * DM) + lane;
#pragma unroll
        for (int q = 0; q < 8; ++q) { const f32x4 g0 = gp[128 * q], g1 = gp[128 * q + 1], c0 = scp[128 * q], c1 = scp[128 * q + 1], h0 = shp[128 * q], h1 = shp[128 * q + 1];
            const f32x4 x0 = (f32x4){bf_lo(v[q].x), bf_hi(v[q].x), bf_lo(v[q].y), bf_hi(v[q].y)}, x1 = (f32x4){bf_lo(v[q].z), bf_hi(v[q].z), bf_lo(v[q].w), bf_hi(v[q].w)};
            const f32x4 y0 = x0 * rstd * g0 * (c0 + 1.0f) + h0, y1 = x1 * rstd * g1 * (c1 + 1.0f) + h1;
            v4u o; o.x = cvtpk(y0.x, y0.y); o.y = cvtpk(y0.z, y0.w); o.z = cvtpk(y1.x, y1.y); o.w = cvtpk(y1.z, y1.w); o16[64 * q] = o; }
    }
}
__device__ __forceinline__ void p_modulate_l0(const float* xs_x, const float* ctx, const float* partz, const float* gain, const float* modl, int j, int gslot, bf16* H, int gw, int NGW, int lane) {
    const int nrows = (NGW == 2048) ? (gw < 1024 ? 4 : 5) : (MALL + NGW - 1) / NGW;
    for (int it = 0; it < nrows; ++it) {
        int m;
        if (NGW == 2048) m = (gw < 1024) ? (it == 0 ? MX + gw : gw * 3 + it - 1) : 3072 + (gw - 1024) * 5 + it;
        else { m = gw + it * NGW; if (m >= MALL) break; }
        const bool isx = m < MX; const int bidx = isx ? (m >> 11) : 4;
        const GAS f32x4* gp = (const GAS f32x4*)((const GAS float*)gain) + lane;
        const GAS f32x4* shp = (const GAS f32x4*)((const GAS float*)modl + (size_t)bidx * MODW + (3 * j) * DM) + lane;
        const GAS f32x4* scp = (const GAS f32x4*)((const GAS float*)modl + (size_t)bidx * MODW + (3 * j + 1) * DM) + lane;
        f32x4 v[16]; float s = 0.f;
        if (isx) { const GAS f32x4* xr = (const GAS f32x4*)((const GAS float*)xs_x + (size_t)m * DM) + lane;
#pragma unroll
            for (int q = 0; q < 16; ++q) v[q] = xr[64 * q]; }
        else { const size_t zo = (size_t)(m - MX) * DM; const GAS f32x4* cr = (const GAS f32x4*)((const GAS float*)ctx + zo) + lane;
            const GAS f32x4* gt = (const GAS f32x4*)((const GAS float*)modl + (size_t)4 * MODW + gslot * DM) + lane; const GAS f32x4* pz = (const GAS f32x4*)((const GAS float*)partz + zo) + lane;
#pragma unroll
            for (int q = 0; q < 16; ++q) { const f32x4 p = (pz[64 * q] + pz[64 * q + (size_t)MZ * DM / 4]) + (pz[64 * q + (size_t)2 * MZ * DM / 4] + pz[64 * q + (size_t)3 * MZ * DM / 4]);
                v[q] = cr[64 * q] + gt[64 * q] * 0.5f * p; } }
#pragma unroll
        for (int q = 0; q < 16; ++q) s += (v[q].x * v[q].x + v[q].y * v[q].y) + (v[q].z * v[q].z + v[q].w * v[q].w);
        const float rstd = 1.0f / sqrtf(wave_sum(s) * (1.0f / DM) + EPS);
        GAS v2u* o8 = (GAS v2u*)((GAS bf16*)H + (size_t)m * DM) + lane;
#pragma unroll
        for (int q = 0; q < 16; ++q) { const f32x4 g = gp[64 * q], sc = scp[64 * q], sh = shp[64 * q];
            const f32x4 y = v[q] * rstd * g * (sc + 1.0f) + sh; v2u o; o.x = cvtpk(y.x, y.y); o.y = cvtpk(y.z, y.w); o8[64 * q] = o; }
    }
}
__device__ __forceinline__ void p_sw_reduce(const float* swp, float* sw, int gw, int NGW, int lane) {
    for (int idx = gw * 64 + lane; idx < 5 * 5 * 4096; idx += NGW * 64) {
        const int m = idx / (5 * 4096), b = (idx / 4096) % 5, c4 = idx % 4096; const int N = (m == 0) ? 3 * DM : (m == 4) ? 2 * DM : 2 * DFF;
        if (4 * c4 >= N) continue;
        const size_t mbase = (m == 0) ? 0 : (size_t)64 * 5 * 3 * DM + (size_t)(m - 1) * 64 * 5 * 2 * DFF;
        const GAS f32x4* sp = (const GAS f32x4*)((const GAS float*)swp + mbase + (size_t)b * N) + c4; f32x4 a = (f32x4){0.f, 0.f, 0.f, 0.f};
#pragma unroll 8
        for (int kb = 0; kb < 64; ++kb) a += sp[(size_t)kb * 5 * N / 4];
        *(GAS f32x4*)((GAS float*)sw + ((size_t)m * 5 + b) * 16384 + 4 * c4) = a;
    }
}

#ifndef ATT_STAGGER
#define ATT_STAGGER 0
#endif
#ifndef ATT_PERM
#define ATT_PERM 1
#endif
#ifndef ATT_DPP
#define ATT_DPP 1
#endif
namespace att {
constexpr int SHM_K = 16384, SHM_V = 16384;
constexpr int OFF_V = 0, OFF_K = 3 * SHM_V, OFF_TAB = OFF_K + 2 * SHM_K, OFF_WS = OFF_TAB + 2048;
#define KSWZ(row, colB) ((row) * 256 + ((colB) ^ (((row) & 7) << 4)))
__device__ __forceinline__ int crow(int r, int hi) { return (r & 3) + 8 * (r >> 2) + 4 * hi; }
__device__ __forceinline__ int v_st(int k, int c) { const int kk = (k & ~0xC) | ((k & 4) << 1) | ((k & 8) >> 1); return ((kk >> 3) * 4 + (c >> 5)) * 512 + ((kk & 7) * 32 + (c & 31)) * 2; }
__device__ __forceinline__ int v_rd_base(int lane) { return ((lane & 3) << 3) | (((lane >> 2) & 3) << 6) | (((lane >> 4) & 1) << 5) | (((lane >> 5) & 1) << 8); }
constexpr int v_rd_off(int d0, int ks, int half) { return d0 * 512 + ks * 4096 + half * 2048; }
template <int OFF> __device__ __forceinline__ s16x4 tr_read(int vb) {
    s16x4 r; asm volatile("ds_read_b64_tr_b16 %0, %1 offset:%2" : "=&v"(r) : "v"(vb), "i"(OFF) : "memory"); return r;
}
template <int D0> __device__ __forceinline__ void pv_one(f32x16& od, int vb, bf16x8 pa0, bf16x8 pa1, bf16x8 pa2, bf16x8 pa3) {
    const s16x4 l0 = tr_read<v_rd_off(D0, 0, 0)>(vb), h0 = tr_read<v_rd_off(D0, 0, 1)>(vb), l1 = tr_read<v_rd_off(D0, 1, 0)>(vb), h1 = tr_read<v_rd_off(D0, 1, 1)>(vb);
    const s16x4 l2 = tr_read<v_rd_off(D0, 2, 0)>(vb), h2 = tr_read<v_rd_off(D0, 2, 1)>(vb), l3 = tr_read<v_rd_off(D0, 3, 0)>(vb), h3 = tr_read<v_rd_off(D0, 3, 1)>(vb);
    asm volatile("s_waitcnt lgkmcnt(0)" ::: "memory"); SBAR();
#define PKLH(L, H) (bf16x8){L[0], L[1], L[2], L[3], H[0], H[1], H[2], H[3]}
    od = __builtin_amdgcn_mfma_f32_32x32x16_bf16(pa0, PKLH(l0, h0), od, 0, 0, 0);
    od = __builtin_amdgcn_mfma_f32_32x32x16_bf16(pa1, PKLH(l1, h1), od, 0, 0, 0);
    od = __builtin_amdgcn_mfma_f32_32x32x16_bf16(pa2, PKLH(l2, h2), od, 0, 0, 0);
    od = __builtin_amdgcn_mfma_f32_32x32x16_bf16(pa3, PKLH(l3, h3), od, 0, 0, 0);
}
template <int D0> __device__ __forceinline__ void vt_one(f32x16& od, int vb, bf16x8 pa0, bf16x8 pa1, bf16x8 pa2, bf16x8 pa3) {
    const s16x4 l0 = tr_read<v_rd_off(D0, 0, 0)>(vb), h0 = tr_read<v_rd_off(D0, 0, 1)>(vb), l1 = tr_read<v_rd_off(D0, 1, 0)>(vb), h1 = tr_read<v_rd_off(D0, 1, 1)>(vb);
    const s16x4 l2 = tr_read<v_rd_off(D0, 2, 0)>(vb), h2 = tr_read<v_rd_off(D0, 2, 1)>(vb), l3 = tr_read<v_rd_off(D0, 3, 0)>(vb), h3 = tr_read<v_rd_off(D0, 3, 1)>(vb);
    asm volatile("s_waitcnt lgkmcnt(0)" ::: "memory"); SBAR();
    od = __builtin_amdgcn_mfma_f32_32x32x16_bf16(PKLH(l0, h0), pa0, od, 0, 0, 0);
    od = __builtin_amdgcn_mfma_f32_32x32x16_bf16(PKLH(l1, h1), pa1, od, 0, 0, 0);
    od = __builtin_amdgcn_mfma_f32_32x32x16_bf16(PKLH(l2, h2), pa2, od, 0, 0, 0);
    od = __builtin_amdgcn_mfma_f32_32x32x16_bf16(PKLH(l3, h3), pa3, od, 0, 0, 0);
}
__device__ __forceinline__ void qkt_acc(f32x16& p0, f32x16& p1, const LAS unsigned char* Ks, const bf16x8* qr, int r32, int hi) {
#pragma unroll
    for (int d0 = 0; d0 < 8; ++d0) { const int cb = (d0 * 16 + hi * 8) * 2;
        const bf16x8 b0 = *(const LAS bf16x8*)(Ks + KSWZ(r32, cb));
        const bf16x8 b1 = *(const LAS bf16x8*)(Ks + KSWZ(32 + r32, cb));
        p0 = __builtin_amdgcn_mfma_f32_32x32x16_bf16(b0, qr[d0], p0, 0, 0, 0);
        p1 = __builtin_amdgcn_mfma_f32_32x32x16_bf16(b1, qr[d0], p1, 0, 0, 0); }
}
__device__ __forceinline__ bf16x8 knorm8(v4u raw, const float (&kg)[8]) {
    float x[8]; x[0] = bf_lo(raw.x); x[1] = bf_hi(raw.x); x[2] = bf_lo(raw.y); x[3] = bf_hi(raw.y); x[4] = bf_lo(raw.z); x[5] = bf_hi(raw.z); x[6] = bf_lo(raw.w); x[7] = bf_hi(raw.w);
    float ss = 0.f;
#pragma unroll
    for (int j = 0; j < 8; ++j) ss += x[j] * x[j];
#if ATT_DPP
    ss += __builtin_bit_cast(float, __builtin_amdgcn_update_dpp(0, __builtin_bit_cast(int, ss), 0xB1, 0xF, 0xF, true));
    ss += __builtin_bit_cast(float, __builtin_amdgcn_update_dpp(0, __builtin_bit_cast(int, ss), 0x4E, 0xF, 0xF, true));
    ss += __builtin_bit_cast(float, __builtin_amdgcn_update_dpp(0, __builtin_bit_cast(int, ss), 0x141, 0xF, 0xF, true));
    ss += __builtin_bit_cast(float, __builtin_amdgcn_update_dpp(0, __builtin_bit_cast(int, ss), 0x140, 0xF, 0xF, true));
#else
    ss += __shfl_xor(ss, 1); ss += __shfl_xor(ss, 2); ss += __shfl_xor(ss, 4); ss += __shfl_xor(ss, 8);
#endif
    const float rstd = 1.0f / sqrtf(ss * (1.0f / HD) + EPS);
    v4u w; w.x = cvtpk(x[0] * rstd * kg[0], x[1] * rstd * kg[1]); w.y = cvtpk(x[2] * rstd * kg[2], x[3] * rstd * kg[3]);
    w.z = cvtpk(x[4] * rstd * kg[4], x[5] * rstd * kg[5]); w.w = cvtpk(x[6] * rstd * kg[6], x[7] * rstd * kg[7]);
    return __builtin_bit_cast(bf16x8, w);
}
__device__ __forceinline__ void attn_unit(bool lat, int b, int h, int rg, const bf16* QKV, bf16* AO, const float* qgain, const float* kgain, const float* rpb, LAS unsigned char* lds, int tid, int wid, int lane) {
    const int r32 = lane & 31, hi = lane >> 5;
    LAS unsigned char* V_lds = lds + OFF_V; LAS unsigned char* K_lds = lds + OFF_K; LAS float* TAB = (LAS float*)(lds + OFF_TAB);
    LAS float* wsl = (LAS float*)(lds + OFF_WS) + wid * 64; LAS float* li_l = wsl; LAS float* al_l = wsl + 32;
    constexpr int LDQ = 3 * DM;
    const int rq = 4 * rg + (wid >> 1);
    const int klo = lat ? min(max(4 * rg - 4, 0), 24) : 0, khi = lat ? min(max(4 * rg - 1, 0), 24) + 7 : -1, nlat = khi - klo + 1, ntile = nlat + 4;
    const int r0q = min(max(rq - 4, 0), 24);
    const int qrow0 = lat ? b * SEQ + 64 * rq + 32 * (wid & 1) : MX + b * CTX + 32 * wid;
    const int cq = 32 * (wid & 1) + r32, cs = min(max(cq - 8, 0), 48);
    if (lat && tid < 480) { const int i = tid & 31; TAB[tid] = (i < 31) ? ((const GAS float*)rpb)[h * 465 + (tid >> 5) * 31 + i] * LOG2E : -1e30f; }
    bf16x8 qr[8];
    { const GAS bf16* Qp = (const GAS bf16*)QKV + (size_t)(qrow0 + r32) * LDQ + h * HD + hi * 8;
      v4u raw[8]; float ss = 0.f;
#pragma unroll
      for (int d0 = 0; d0 < 8; ++d0) { raw[d0] = *(const GAS v4u*)(Qp + d0 * 16);
          const float a0 = bf_lo(raw[d0].x), a1 = bf_hi(raw[d0].x), a2 = bf_lo(raw[d0].y), a3 = bf_hi(raw[d0].y), a4 = bf_lo(raw[d0].z), a5 = bf_hi(raw[d0].z), a6 = bf_lo(raw[d0].w), a7 = bf_hi(raw[d0].w);
          ss += (a0 * a0 + a1 * a1) + (a2 * a2 + a3 * a3) + (a4 * a4 + a5 * a5) + (a6 * a6 + a7 * a7); }
      ss += __shfl_xor(ss, 32);
      const float sc = (1.0f / sqrtf(ss * (1.0f / HD) + EPS)) * (0.08838834764831845f * LOG2E);
#pragma unroll
      for (int d0 = 0; d0 < 8; ++d0) { const GAS f32x4* gq = (const GAS f32x4*)((const GAS float*)qgain + d0 * 16 + hi * 8); const f32x4 g0 = gq[0], g1 = gq[1];
          v4u w; w.x = cvtpk(bf_lo(raw[d0].x) * sc * g0.x, bf_hi(raw[d0].x) * sc * g0.y); w.y = cvtpk(bf_lo(raw[d0].y) * sc * g0.z, bf_hi(raw[d0].y) * sc * g0.w);
          w.z = cvtpk(bf_lo(raw[d0].z) * sc * g1.x, bf_hi(raw[d0].z) * sc * g1.y); w.w = cvtpk(bf_lo(raw[d0].w) * sc * g1.z, bf_hi(raw[d0].w) * sc * g1.w);
          qr[d0] = __builtin_bit_cast(bf16x8, w); } }
    const int sr = tid >> 4, sc8 = (tid & 15) * 8, vst0 = v_st(sr, sc8), vst1 = v_st(32 + sr, sc8), kst0 = KSWZ(sr, sc8 * 2), kst1 = KSWZ(32 + sr, sc8 * 2);
    float kg[8];
    { const GAS f32x4* gk = (const GAS f32x4*)((const GAS float*)kgain + sc8); const f32x4 g0 = gk[0], g1 = gk[1]; kg[0] = g0.x; kg[1] = g0.y; kg[2] = g0.z; kg[3] = g0.w; kg[4] = g1.x; kg[5] = g1.y; kg[6] = g1.z; kg[7] = g1.w; }
    const int vb0 = (int)(uintptr_t)V_lds + v_rd_base(lane);
    v4u ks0, ks1, vs0, vs1;
#define ATT_KROW(jt) ((jt) < nlat ? b * SEQ + 64 * (klo + (jt)) : MX + b * CTX + 64 * ((jt) - nlat))
#define ATT_SLOAD(jt) do { const GAS bf16* kp = (const GAS bf16*)QKV + (size_t)(ATT_KROW(jt) + sr) * LDQ + DM + h * HD + sc8; \
        ks0 = *(const GAS v4u*)kp; ks1 = *(const GAS v4u*)(kp + (size_t)32 * LDQ); vs0 = *(const GAS v4u*)(kp + DM); vs1 = *(const GAS v4u*)(kp + (size_t)32 * LDQ + DM); } while (0)
#define ATT_SWRITE(kbufi, vbufi) do { *(LAS v4u*)(V_lds + (vbufi) * SHM_V + vst0) = vs0; *(LAS v4u*)(V_lds + (vbufi) * SHM_V + vst1) = vs1; \
        *(LAS bf16x8*)(K_lds + (kbufi) * SHM_K + kst0) = knorm8(ks0, kg); *(LAS bf16x8*)(K_lds + (kbufi) * SHM_K + kst1) = knorm8(ks1, kg); } while (0)
    unsigned bo0[4] = {0u, 0u, 0u, 0u}, bo1[4] = {0u, 0u, 0u, 0u};
#pragma unroll
    for (int r = 0; r < 16; ++r) { const int ck0 = crow(r, hi), ck1 = 32 + ck0;
        bo0[r >> 2] |= (unsigned)(4 * (((unsigned)(ck0 - cs) < 16u) ? (ck0 - cq + 15) : 31)) << (8 * (r & 3));
        bo1[r >> 2] |= (unsigned)(4 * (((unsigned)(ck1 - cs) < 16u) ? (ck1 - cq + 15) : 31)) << (8 * (r & 3)); }
    float m_reg = -1e30f, l_reg = 0.f; f32x16 o[4];
#pragma unroll
    for (int d = 0; d < 4; ++d)
#pragma unroll
        for (int r = 0; r < 16; ++r) o[d][r] = 0.f;
    ATT_SLOAD(0); ATT_SWRITE(0, 0); __syncthreads();
    const bool upper = ATT_STAGGER && wid >= 4; bool pend = false; int pvb = 0, vbuf = 0;
    bf16x8 pa0, pa1, pa2, pa3; { const v4u z_ = {0u, 0u, 0u, 0u}; pa0 = pa1 = pa2 = pa3 = __builtin_bit_cast(bf16x8, z_); }
    for (int jt = 0; jt < ntile; ++jt) {
        const int buf = jt & 1; const int vnext = (vbuf == 2) ? 0 : vbuf + 1;
        if (jt + 1 < ntile) ATT_SLOAD(jt + 1);
        if (upper && pend) { vt_one<0>(o[0], pvb, pa0, pa1, pa2, pa3); vt_one<1>(o[1], pvb, pa0, pa1, pa2, pa3); vt_one<2>(o[2], pvb, pa0, pa1, pa2, pa3); vt_one<3>(o[3], pvb, pa0, pa1, pa2, pa3); pend = false; }
        const bool islat = jt < nlat; const int kr = klo + jt;
        const bool active = !islat || (kr >= r0q && kr <= r0q + 7);
        if (active) {
            f32x16 p0, p1;
            if (islat) { const LAS unsigned char* trow = (const LAS unsigned char*)(TAB + (kr - rq + 7) * 32);
                asm volatile("" : "+v"(bo0[0]), "+v"(bo0[1]), "+v"(bo0[2]), "+v"(bo0[3]), "+v"(bo1[0]), "+v"(bo1[1]), "+v"(bo1[2]), "+v"(bo1[3]));
#pragma unroll
                for (int r = 0; r < 16; ++r) { p0[r] = *(const LAS float*)(trow + ((bo0[r >> 2] >> (8 * (r & 3))) & 0xffu)); p1[r] = *(const LAS float*)(trow + ((bo1[r >> 2] >> (8 * (r & 3))) & 0xffu)); } }
            else {
#pragma unroll
                for (int r = 0; r < 16; ++r) { p0[r] = 0.f; p1[r] = 0.f; } }
            LDS_WAIT();
            qkt_acc(p0, p1, K_lds + buf * SHM_K, qr, r32, hi);
            float pmax = p0[0];
#pragma unroll
            for (int r = 1; r < 16; ++r) pmax = fmaxf(pmax, p0[r]);
#pragma unroll
            for (int r = 0; r < 16; ++r) pmax = fmaxf(pmax, p1[r]);
#if ATT_PERM
            { unsigned pa_ = __builtin_bit_cast(unsigned, pmax), pb_ = pa_; swap32(pa_, pb_);
              pmax = fmaxf(__builtin_bit_cast(float, pa_), __builtin_bit_cast(float, pb_)); }
#else
            pmax = fmaxf(pmax, __shfl_xor(pmax, 32));
#endif
            float mn = m_reg, alpha = 1.f;
            if (!__all(pmax - m_reg <= 8.0f)) { mn = fmaxf(m_reg, pmax); alpha = __builtin_amdgcn_exp2f(m_reg - mn); m_reg = mn; }
            float ps = 0.f;
#pragma unroll
            for (int r = 0; r < 16; ++r) { p0[r] = __builtin_amdgcn_exp2f(p0[r] - mn); p1[r] = __builtin_amdgcn_exp2f(p1[r] - mn); ps += p0[r] + p1[r]; }
#if ATT_PERM
            { unsigned pa_ = __builtin_bit_cast(unsigned, ps), pb_ = pa_; swap32(pa_, pb_);
              ps = __builtin_bit_cast(float, pa_) + __builtin_bit_cast(float, pb_); }
#else
            ps += __shfl_xor(ps, 32);
#endif
            l_reg = l_reg * alpha + ps;
            if (__any(alpha < 1.f)) {
#pragma unroll
                for (int d = 0; d < 4; ++d)
#pragma unroll
                    for (int r = 0; r < 16; ++r) o[d][r] *= alpha; }
#define ATT_PK4(P, BASE, OUT) do { const unsigned a0 = cvtpk(P[BASE + 0], P[BASE + 1]), a1 = cvtpk(P[BASE + 2], P[BASE + 3]); \
        const unsigned b0 = cvtpk(P[BASE + 4], P[BASE + 5]), b1 = cvtpk(P[BASE + 6], P[BASE + 7]); \
        auto r0_ = __builtin_amdgcn_permlane32_swap(a0, b0, false, false); auto r1_ = __builtin_amdgcn_permlane32_swap(a1, b1, false, false); \
        v4u w_ = {r0_[0], r1_[0], r0_[1], r1_[1]}; OUT = __builtin_bit_cast(bf16x8, w_); } while (0)
            ATT_PK4(p0, 0, pa0); ATT_PK4(p0, 8, pa1); ATT_PK4(p1, 0, pa2); ATT_PK4(p1, 8, pa3);
            const int vb = vb0 + vbuf * SHM_V;
            if (!upper) { vt_one<0>(o[0], vb, pa0, pa1, pa2, pa3); vt_one<1>(o[1], vb, pa0, pa1, pa2, pa3); vt_one<2>(o[2], vb, pa0, pa1, pa2, pa3); vt_one<3>(o[3], vb, pa0, pa1, pa2, pa3); }
            else { pend = true; pvb = vb; }
        }
        if (jt + 1 < ntile) ATT_SWRITE(buf ^ 1, vnext);
        vbuf = vnext;
        __syncthreads();
    }
    if (upper && pend) { vt_one<0>(o[0], pvb, pa0, pa1, pa2, pa3); vt_one<1>(o[1], pvb, pa0, pa1, pa2, pa3); vt_one<2>(o[2], pvb, pa0, pa1, pa2, pa3); vt_one<3>(o[3], pvb, pa0, pa1, pa2, pa3); }
    { const float rl = __builtin_amdgcn_rcpf(l_reg);
      GAS bf16* Ow = (GAS bf16*)AO + (size_t)(qrow0 + r32) * DM + h * HD + 8 * hi;
#pragma unroll
      for (int d0 = 0; d0 < 4; ++d0)
#pragma unroll
          for (int gp = 0; gp < 2; ++gp) { float lo4[4], hi4[4];
#pragma unroll
              for (int e = 0; e < 4; ++e) { unsigned a_ = __builtin_bit_cast(unsigned, o[d0][8 * gp + e] * rl), b_ = __builtin_bit_cast(unsigned, o[d0][8 * gp + 4 + e] * rl); swap32(a_, b_);
                  lo4[e] = __builtin_bit_cast(float, a_); hi4[e] = __builtin_bit_cast(float, b_); }
              v4u w; w.x = cvtpk(lo4[0], lo4[1]); w.y = cvtpk(lo4[2], lo4[3]); w.z = cvtpk(hi4[0], hi4[1]); w.w = cvtpk(hi4[2], hi4[3]);
              *(GAS v4u*)(Ow + d0 * 32 + gp * 16) = w; } }
    __syncthreads();
#undef ATT_KROW
#undef ATT_SLOAD
#undef ATT_SWRITE
#undef ATT_PK4
}
#undef PKLH
}

namespace sgm {
__device__ __forceinline__ void mix_unit(int n, int g, const bf16* U, const bf16* V, bf16* T, const float* ssp, const float* ws, const float* bs, const float* vgain, LAS unsigned char* lds, int tid, int wid, int lane) {
    using namespace att;
    const int r32 = lane & 31, hi = lane >> 5;
    LAS float* RST = (LAS float*)(lds + 131072);
    const int row0 = n * 128, colg = g * 512;
    if (tid < 128) { const GAS f32x4* sp = (const GAS f32x4*)((const GAS float*)ssp + (size_t)(row0 + tid) * 64); f32x4 s = sp[0];
#pragma unroll
        for (int j = 1; j < 16; ++j) s += sp[j];
        RST[tid] = 1.0f / sqrtf(((s.x + s.y) + (s.z + s.w)) * (1.0f / DM) + EPS); }
    { const int sr = tid >> 4, sc8 = (tid & 15) * 8, vst0 = v_st(sr, sc8), vst1 = v_st(32 + sr, sc8);
      v4u a[8], bq[8];
#pragma unroll
      for (int im = 0; im < 8; ++im) { const int kt = im >> 2, ct = im & 3; const GAS bf16* vp = (const GAS bf16*)V + (size_t)(row0 + kt * 64 + sr) * DM + colg + ct * 128 + sc8;
          a[im] = *(const GAS v4u*)vp; bq[im] = *(const GAS v4u*)(vp + (size_t)32 * DM); }
#pragma unroll
      for (int im = 0; im < 8; ++im) { *(LAS v4u*)(lds + im * SHM_V + vst0) = a[im]; *(LAS v4u*)(lds + im * SHM_V + vst1) = bq[im]; } }
    __syncthreads();
    const int pb = wid & 3, ch = wid >> 2;
    bf16x8 pa[8];
    { const GAS float* wp = (const GAS float*)ws + ((size_t)g * 128 + pb * 32 + r32) * 128 + hi * 8;
#pragma unroll
      for (int ks = 0; ks < 8; ++ks) { const f32x4 w0 = *(const GAS f32x4*)(wp + ks * 16), w1 = *(const GAS f32x4*)(wp + ks * 16 + 4); const LAS float* rs = RST + ks * 16 + hi * 8;
          v4u w; w.x = cvtpk(w0.x * rs[0], w0.y * rs[1]); w.y = cvtpk(w0.z * rs[2], w0.w * rs[3]); w.z = cvtpk(w1.x * rs[4], w1.y * rs[5]); w.w = cvtpk(w1.z * rs[6], w1.w * rs[7]);
          pa[ks] = __builtin_bit_cast(bf16x8, w); } }
    const float bsv = ((const GAS float*)bs)[g * 128 + pb * 32 + r32];
    const int vbl = (int)(uintptr_t)lds + v_rd_base(lane);
#pragma unroll
    for (int cc = 0; cc < 2; ++cc) { const int ct = 2 * ch + cc;
        f32x16 acc[4];
#pragma unroll
        for (int d = 0; d < 4; ++d)
#pragma unroll
            for (int r = 0; r < 16; ++r) acc[d][r] = 0.f;
#pragma unroll
        for (int kt = 0; kt < 2; ++kt) { const int vb = vbl + (kt * 4 + ct) * SHM_V;
            vt_one<0>(acc[0], vb, pa[kt * 4 + 0], pa[kt * 4 + 1], pa[kt * 4 + 2], pa[kt * 4 + 3]); vt_one<1>(acc[1], vb, pa[kt * 4 + 0], pa[kt * 4 + 1], pa[kt * 4 + 2], pa[kt * 4 + 3]);
            vt_one<2>(acc[2], vb, pa[kt * 4 + 0], pa[kt * 4 + 1], pa[kt * 4 + 2], pa[kt * 4 + 3]); vt_one<3>(acc[3], vb, pa[kt * 4 + 0], pa[kt * 4 + 1], pa[kt * 4 + 2], pa[kt * 4 + 3]); }
        const size_t rowb = (size_t)(row0 + pb * 32 + r32) * DM; const int colb = colg + ct * 128 + 8 * hi, colp = colg + ct * 128 + 4 * hi;
#pragma unroll
        for (int d0 = 0; d0 < 4; ++d0)
#pragma unroll
            for (int gp = 0; gp < 2; ++gp) {
                const f32x4 va = *(const GAS f32x4*)((const GAS float*)vgain + colp + d0 * 32 + gp * 16), vb_ = *(const GAS f32x4*)((const GAS float*)vgain + colp + d0 * 32 + gp * 16 + 8);
                float lo4[4], hi4[4];
#pragma unroll
                for (int e = 0; e < 4; ++e) { unsigned a_ = __builtin_bit_cast(unsigned, va[e] * acc[d0][8 * gp + e]), b_ = __builtin_bit_cast(unsigned, vb_[e] * acc[d0][8 * gp + 4 + e]); swap32(a_, b_);
                    lo4[e] = __builtin_bit_cast(float, a_); hi4[e] = __builtin_bit_cast(float, b_); }
                const int col = colb + d0 * 32 + gp * 16;
                const v4u uu = *(const GAS v4u*)((const GAS bf16*)U + rowb + col);
                v4u o; o.x = cvtpk(bf_lo(uu.x) * (lo4[0] + bsv), bf_hi(uu.x) * (lo4[1] + bsv)); o.y = cvtpk(bf_lo(uu.y) * (lo4[2] + bsv), bf_hi(uu.y) * (lo4[3] + bsv));
                o.z = cvtpk(bf_lo(uu.z) * (hi4[0] + bsv), bf_hi(uu.z) * (hi4[1] + bsv)); o.w = cvtpk(bf_lo(uu.w) * (hi4[2] + bsv), bf_hi(uu.w) * (hi4[3] + bsv));
                *(GAS v4u*)((GAS bf16*)T + rowb + col) = o; }
    }
    __syncthreads();
}
}

#ifndef MK_PER_PHASE
#define MK_PER_PHASE 0
#endif
constexpr int N_PHASES = 22;
#ifndef FUSE_MOD
#define FUSE_MOD 0
#endif
#ifndef XGTEST
#define XGTEST 0
#endif
#ifndef MOD_WAVES
#define MOD_WAVES 8
#endif
#ifndef CVT_WAVES
#define CVT_WAVES 4
#endif
static_assert(CVT_WAVES <= 7 && MK_PER_PHASE == 0 || !FUSE_MOD, "conversion scratch: 17920 B per wave inside the 132 KiB ring");
#ifndef PROBE_ORDER
#define PROBE_ORDER StaticOrder
#endif
#ifndef PROBE_PHASE
#define PROBE_PHASE -1
#endif
struct Args {
    const float *x, *c, *ctx, *cctx, *wada, *bada, *normg, *fwin, *fwout, *wqkv, *wo, *qgain, *kgain, *rpb, *sgwin, *sgbin, *sgvgain, *sgws, *sgbs, *sgwout;
    float* out; unsigned char* ws; int ph_lo, ph_hi;
};
__global__ void __launch_bounds__(NWAVES * 64, 2) fwd_kernel(Args args) {
    extern __shared__ __attribute__((aligned(16))) unsigned char lds_raw[];
    LAS unsigned char* lds = (LAS unsigned char*)lds_raw;
    volatile LAS unsigned* MISC = (volatile LAS unsigned*)(lds + MISC_OFF);
    const int wave = __builtin_amdgcn_readfirstlane(threadIdx.x >> 6);
    const int G = gridDim.x, bx = blockIdx.x;
#define LANE_TID() const int lane = lane_now(); const int tid = wave * 64 + lane; (void)tid
    const int vcu = (G % 8 == 0) ? (bx % 8) * (G / 8) + bx / 8 : bx;
    const int gw = vcu * NWAVES + wave, NGW = G * NWAVES;
    const int mgw = vcu * MOD_WAVES + wave, mNGW = G * MOD_WAVES;
    unsigned char* ws = args.ws;
    unsigned* ctl = (unsigned*)(ws + WS_CTL);
    float* MOD = (float*)(ws + WS_MOD); float* SSP = (float*)(ws + WS_SSP); float* PART = (float*)(ws + WS_PART);
    bf16* WIN = (bf16*)(ws + WS_WIN); bf16* WOUT = (bf16*)(ws + WS_WOUT); bf16* WQKV = (bf16*)(ws + WS_WQKV); bf16* WO = (bf16*)(ws + WS_WO);
    bf16* SGIN = (bf16*)(ws + WS_SGIN); bf16* SGOUT = (bf16*)(ws + WS_SGOUT);
    bf16* H = (bf16*)(ws + WS_H); bf16* ACT = (bf16*)(ws + WS_ACT); bf16* QKV = (bf16*)(ws + WS_QKV); bf16* AO = (bf16*)(ws + WS_AO);
    float* SWP = (float*)(ws + WS_SWP); float* SW = (float*)(ws + WS_SW); (void)SW;
    float* XSX = (float*)(ws + WS_XS); float* XSZ = XSX + (size_t)MX * DM;
        bf16* UB = (bf16*)(ws + WS_U); bf16* VB = (bf16*)(ws + WS_V); bf16* TB = (bf16*)(ws + WS_T);
    { LANE_TID(); for (int u = tid; u < (LDS_BYTES - MISC_OFF) / 4; u += NWAVES * 64) ((LAS unsigned*)(lds + MISC_OFF))[u] = 0u; }
    __syncthreads();
    XcdBarrier bar; bar.bar = ctl + CW_BAR; bar.x = 0; bar.st = nullptr;
    if (!MK_PER_PHASE) bar = xcd_barrier_post(ctl + CW_BAR, MISC + 8);
    const int lo = args.ph_lo, hi = args.ph_hi;
#define IN(k) (lo <= (k) && (k) < hi)
#define SEAM(k) do { if (!MK_PER_PHASE && IN(k) && IN((k) + 1)) xcd_barrier(bar); } while (0)
#define GEMM_PHASE(EpiT, Aptr, Bptr, Mv, Nv, Kv, ...) do { pg8::Gemm g_{(const pg8::bf16_t*)(Aptr), (const pg8::bf16_t*)(Bptr), (Mv), (Nv), (Kv), (Kv)}; pg8::StaticOrder S_; S_.init((Mv), (Nv), G, bx); \
        pg8::EpiT E_{__VA_ARGS__}; { LANE_TID(); pg8::gemm_phase<pg8::EpiT, pg8::StaticOrder, GK_ALIGN, GK_SP2>(lds, g_, S_, E_, tid); } } while (0)
#define RESID_PHASE(Aptr, Bptr, Kv, RIN, OUT, O_MODv, GSLOTv, GS2v, NGIDX, O_NMODv, NSLOTv, HASXG) do { typedef pg8::EpiResid<WS_XS, (O_MODv), WS_XB, WS_SSQ, (GSLOTv), (GS2v), WS_NG + (size_t)(NGIDX) * DM * 4, (O_NMODv), (NSLOTv), (HASXG)> Epi_; \
        pg8::Gemm g_{(const pg8::bf16_t*)(Aptr), (const pg8::bf16_t*)(Bptr), MX, DM, (Kv), (Kv)}; pg8::StaticOrder S_; S_.init(MX, DM, G, bx); Epi_ E_{ws, (RIN), (OUT)}; \
        { LANE_TID(); pg8::gemm_phase<Epi_, pg8::StaticOrder, GK_ALIGN, GK_SP2>(lds, g_, S_, E_, tid); } } while (0)
    constexpr size_t WS_MOD1 = WS_MOD + (size_t)5 * MODW * 4;
    const size_t WIN_SZ = (size_t)2 * DFF * DM, WOUT_SZ = (size_t)DM * DFF;

    for (int rep_ = 0; rep_ < ((PROBE_PHASE == 0) ? 2 : 1); ++rep_) { if (rep_) xcd_barrier(bar);
    if (IN(0)) { LANE_TID(); p_ada_partial(args.c, args.cctx, args.wada, PART, lds, vcu, G, tid, wave, lane); } } SEAM(0);
#define CVT_SET(NM, M0, M1, M2, M3, M4, M5, M6, RANK, NRANKS) do { const int mats_[7] = {M0, M1, M2, M3, M4, M5, M6}; int tot_ = 0; \
        _Pragma("unroll") for (int q_ = 0; q_ < (NM); ++q_) tot_ += cvt_items_of(mats_[q_]); \
        LAS float* scr_ = (LAS float*)(lds + wave * 17920); \
        for (int it_ = (RANK); it_ < tot_; it_ += (NRANKS)) { int r_ = it_, mat_ = mats_[0]; \
            _Pragma("unroll") for (int q_ = 0; q_ < (NM) - 1; ++q_) { const int n_ = cvt_items_of(mats_[q_]); if (mat_ == mats_[q_] && r_ >= n_) { r_ -= n_; mat_ = mats_[q_ + 1]; } } \
            const float* src_; bf16* dst_; int K_, N_; bool sw_ = false; const float* shv_ = nullptr; float* swp_ = nullptr; \
            if (mat_ < 4) { src_ = args.fwin + (size_t)mat_ * WIN_SZ; dst_ = WIN + (size_t)mat_ * WIN_SZ; K_ = DM; N_ = 2 * DFF; sw_ = true; \
                if (mat_ > 0) { shv_ = MOD + (size_t)(mat_ == 1 ? 0 : 5) * MODW + (size_t)(mat_ == 2 ? 0 : 6) * DM; swp_ = SWP + (size_t)64 * 5 * 3 * DM + (size_t)(mat_ - 1) * 64 * 5 * 2 * DFF; } } \
            else if (mat_ < 8) { src_ = args.fwout + (size_t)(mat_ - 4) * WOUT_SZ; dst_ = WOUT + (size_t)(mat_ - 4) * WOUT_SZ; K_ = DFF; N_ = DM; } \
            else if (mat_ == 8) { src_ = args.wqkv; dst_ = WQKV; K_ = DM; N_ = 3 * DM; shv_ = MOD + (size_t)3 * DM; swp_ = SWP; } \
            else if (mat_ == 9) { src_ = args.wo; dst_ = WO; K_ = DM; N_ = DM; } \
            else if (mat_ == 10) { src_ = args.sgwin; dst_ = SGIN; K_ = DM; N_ = 2 * DM; shv_ = MOD + (size_t)5 * MODW + (size_t)3 * DM; swp_ = SWP + (size_t)64 * 5 * 3 * DM + (size_t)3 * 64 * 5 * 2 * DFF; } \
            else { src_ = args.sgwout; dst_ = SGOUT; K_ = DM; N_ = DM; } \
            cvt_item(src_, K_, N_, dst_, sw_, scr_, r_, lane, FUSE_MOD ? shv_ : nullptr, swp_); } } while (0)
    for (int rep_ = 0; rep_ < ((PROBE_PHASE == 1) ? 2 : 1); ++rep_) { if (rep_) xcd_barrier(bar);
    if (IN(1)) { LANE_TID();
        p_mod_finalize(PART, args.bada, MOD, gw, NGW, lane); p_copy_normg(args.normg, (float*)(ws + WS_NG), gw, NGW, lane);
        if (FUSE_MOD && !MK_PER_PHASE) xcd_barrier(bar);
#if CVT_WAVES == 8
        CVT_SET(7, 0, 4, 2, 6, 10, 3, 7, gw, NGW); CVT_SET(3, 8, 9, 1, 1, 1, 1, 1, gw, NGW); CVT_SET(2, 5, 11, 11, 11, 11, 11, 11, gw, NGW);
#else
        if (wave < CVT_WAVES) { const int gw2 = vcu * CVT_WAVES + wave, ngw2 = G * CVT_WAVES;
        CVT_SET(7, 0, 4, 2, 6, 10, 3, 7, gw2, ngw2); CVT_SET(3, 8, 9, 1, 1, 1, 1, 1, gw2, ngw2); CVT_SET(2, 5, 11, 11, 11, 11, 11, 11, gw2, ngw2); }
#endif
    } } SEAM(1);
    for (int rep_ = 0; rep_ < ((PROBE_PHASE == 2) ? 2 : 1); ++rep_) { if (rep_) xcd_barrier(bar);
    if (IN(2)) { LANE_TID(); if (wave < MOD_WAVES) p_modulate(args.x, args.ctx, args.normg + 0 * DM, MOD, 0, H, MALL, mgw, mNGW, lane); if (FUSE_MOD) p_sw_reduce(SWP, SW, gw, NGW, lane); } } SEAM(2);
    for (int rep_ = 0; rep_ < ((PROBE_PHASE == 3) ? 2 : 1); ++rep_) { if (rep_) xcd_barrier(bar);
    if (IN(3)) { if (rep_ == 0) { GEMM_PHASE(EpiSwiGLU, H, WIN + 0 * WIN_SZ, MALL, 2 * DFF, DM, ACT, DFF); } else { pg8::Gemm g_{(const pg8::bf16_t*)H, (const pg8::bf16_t*)(WIN), MALL, 2 * DFF, DM, DM}; pg8::PROBE_ORDER S_; S_.init(MALL, 2 * DFF, G, bx); pg8::EpiNull E_{0}; { LANE_TID(); pg8::gemm_phase<pg8::EpiNull, pg8::PROBE_ORDER, GK_ALIGN, GK_SP2>(lds, g_, S_, E_, tid); } } } } SEAM(3);
    for (int rep_ = 0; rep_ < ((PROBE_PHASE == 4) ? 2 : 1); ++rep_) { if (rep_) xcd_barrier(bar);
    if (IN(4)) { RESID_PHASE(ACT, WOUT + 0 * WOUT_SZ, DFF, args.x, nullptr, WS_MOD, 2, 1, 1, WS_MOD, 4, XGTEST != 0);
        { pg8::Gemm g_{(const pg8::bf16_t*)ACT, (const pg8::bf16_t*)(WOUT), MALL, DM, 2048, DFF}; pg8::ZSplitOrder S_; S_.init(G, bx); pg8::EpiPart E_{(float*)(ws + WS_PARTZ)};
          { LANE_TID(); pg8::gemm_phase<pg8::EpiPart, pg8::ZSplitOrder, GK_ALIGN, GK_SP2>(lds, g_, S_, E_, tid); } } } } SEAM(4);
    for (int rep_ = 0; rep_ < ((PROBE_PHASE == 5) ? 2 : 1); ++rep_) { if (rep_) xcd_barrier(bar);
    if (IN(5)) { LANE_TID(); if (wave < MOD_WAVES) p_modulate_l0(XSX, args.ctx, (const float*)(ws + WS_PARTZ), args.normg + 1 * DM, MOD, 1, 2, H, mgw, mNGW, lane); } } SEAM(5);
    for (int rep_ = 0; rep_ < ((PROBE_PHASE == 6) ? 2 : 1); ++rep_) { if (rep_) xcd_barrier(bar);
    if (IN(6)) { pg8::Gemm g_{(const pg8::bf16_t*)H, (const pg8::bf16_t*)WQKV, MALL, 3 * DM, DM, DM}; pg8::QkvOrder S_; S_.init(G, bx); pg8::EpiBf16 E_{QKV, 3 * DM};
        { LANE_TID(); pg8::gemm_phase<pg8::EpiBf16, pg8::QkvOrder, GK_ALIGN, GK_SP2>(lds, g_, S_, E_, tid); } } } SEAM(6);
    for (int rep_ = 0; rep_ < ((PROBE_PHASE == 7) ? 2 : 1); ++rep_) { if (rep_) xcd_barrier(bar);
    if (IN(7)) { LANE_TID();
        for (int u = vcu; u < 1024; u += G) {
            att::attn_unit(true, u >> 8, (u >> 3) & 31, ((u & 7) + 2 * (u >> 8)) & 7, QKV, AO, args.qgain, args.kgain, args.rpb, lds, tid, wave, lane);
        }
    } } SEAM(7);
    if (IN(8)) { RESID_PHASE(AO, WO, DM, nullptr, nullptr, WS_MOD, 5, 2, 2, WS_MOD, 7, XGTEST != 0); } SEAM(8);
    if (IN(9)) { LANE_TID(); if (wave < MOD_WAVES) p_modulate(XSX, XSZ, args.normg + 2 * DM, MOD, 2, H, MX, mgw, mNGW, lane); } SEAM(9);
    if (IN(10)) { GEMM_PHASE(EpiSwiGLU, H, WIN + 1 * WIN_SZ, MX, 2 * DFF, DM, ACT, DFF); } SEAM(10);
    if (IN(11)) { RESID_PHASE(ACT, WOUT + 1 * WOUT_SZ, DFF, nullptr, nullptr, WS_MOD, 8, 1, 3, WS_MOD1, 1, XGTEST != 0); } SEAM(11);
    const float* MOD1 = MOD + 5 * MODW;
    for (int rep_ = 0; rep_ < ((PROBE_PHASE == 12) ? 2 : 1); ++rep_) { if (rep_) xcd_barrier(bar);
    if (IN(12)) { LANE_TID(); if (wave < MOD_WAVES) p_modulate(XSX, XSZ, args.normg + 3 * DM, MOD1, 0, H, MX, mgw, mNGW, lane); } } SEAM(12);
    for (int rep_ = 0; rep_ < ((PROBE_PHASE == 13) ? 2 : 1); ++rep_) { if (rep_) xcd_barrier(bar);
    if (IN(13)) { GEMM_PHASE(EpiSwiGLU, H, WIN + 2 * WIN_SZ, MX, 2 * DFF, DM, ACT, DFF); } } SEAM(13);
    if (IN(14)) { RESID_PHASE(ACT, WOUT + 2 * WOUT_SZ, DFF, nullptr, nullptr, WS_MOD1, 2, 1, 4, WS_MOD1, 4, XGTEST != 0); } SEAM(14);
    for (int rep_ = 0; rep_ < ((PROBE_PHASE == 15) ? 2 : 1); ++rep_) { if (rep_) xcd_barrier(bar);
    if (IN(15)) { LANE_TID(); if (wave < MOD_WAVES) p_modulate(XSX, XSZ, args.normg + 4 * DM, MOD1, 1, H, MX, mgw, mNGW, lane); } } SEAM(15);
    for (int rep_ = 0; rep_ < ((PROBE_PHASE == 16) ? 2 : 1); ++rep_) { if (rep_) xcd_barrier(bar);
    if (IN(16)) { GEMM_PHASE(EpiSG, H, SGIN, MX, 2 * DM, DM, UB, VB, args.sgbin, SSP); } } SEAM(16);
    for (int rep_ = 0; rep_ < ((PROBE_PHASE == 17) ? 2 : 1); ++rep_) { if (rep_) xcd_barrier(bar);
    if (IN(17)) { LANE_TID(); for (int u = vcu; u < 512; u += G) sgm::mix_unit(u >> 3, u & 7, UB, VB, TB, SSP, args.sgws, args.sgbs, args.sgvgain, lds, tid, wave, lane); } } SEAM(17);
    if (IN(18)) { RESID_PHASE(TB, SGOUT, DM, nullptr, nullptr, WS_MOD1, 5, 2, 5, WS_MOD1, 7, XGTEST != 0); } SEAM(18);
    if (IN(19)) { LANE_TID(); if (wave < MOD_WAVES) p_modulate(XSX, XSZ, args.normg + 5 * DM, MOD1, 2, H, MX, mgw, mNGW, lane); } SEAM(19);
    if (IN(20)) { GEMM_PHASE(EpiSwiGLU, H, WIN + 3 * WIN_SZ, MX, 2 * DFF, DM, ACT, DFF); } SEAM(20);
    if (IN(21)) { RESID_PHASE(ACT, WOUT + 3 * WOUT_SZ, DFF, nullptr, args.out, WS_MOD1, 8, 1, 0, WS_MOD1, 0, false); }
#undef IN
#undef SEAM
#undef GEMM_PHASE
#undef RESID_PHASE
#undef CVT_SET
#undef LANE_TID
}

extern "C" void kernel_launch(void* const* d_in, const int* in_sizes, int n_in, void* d_out, int out_size, void* d_ws, size_t ws_size, hipStream_t stream) {
    static int grid = 0;
    if (grid == 0) {
        if (n_in != 20 || in_sizes[0] != MX * DM || out_size != MX * DM || ws_size < WS_END) { fprintf(stderr, "kernel_launch: unexpected shapes (n_in %d, in0 %d, out %d, ws %zu)\n", n_in, n_in > 0 ? in_sizes[0] : -1, out_size, ws_size); grid = -1; return; }
        int dev = 0, cus = 0, per_cu = 0;
        if (hipGetDevice(&dev) != hipSuccess || hipDeviceGetAttribute(&cus, hipDeviceAttributeMultiprocessorCount, dev) != hipSuccess) { grid = -1; return; }
        if (hipFuncSetAttribute((const void*)fwd_kernel, hipFuncAttributeMaxDynamicSharedMemorySize, LDS_BYTES) != hipSuccess) { fprintf(stderr, "kernel_launch: hipFuncSetAttribute failed\n"); grid = -1; return; }
        if (hipOccupancyMaxActiveBlocksPerMultiprocessor(&per_cu, (const void*)fwd_kernel, NWAVES * 64, LDS_BYTES) != hipSuccess || per_cu < 1) fprintf(stderr, "kernel_launch: occupancy query reports %d\n", per_cu);
        (void)hipGetLastError();
        grid = cus;
    }
    if (grid < 0) return;
    if (hipMemsetAsync((char*)d_ws + WS_CTL, 0, CTL_ZERO_BYTES, stream) != hipSuccess) { fprintf(stderr, "kernel_launch: memset failed\n"); return; }
    Args a{};
    a.x = (const float*)d_in[0]; a.c = (const float*)d_in[1]; a.ctx = (const float*)d_in[2]; a.cctx = (const float*)d_in[3]; a.wada = (const float*)d_in[4]; a.bada = (const float*)d_in[5];
    a.normg = (const float*)d_in[6]; a.fwin = (const float*)d_in[7]; a.fwout = (const float*)d_in[8]; a.wqkv = (const float*)d_in[9]; a.wo = (const float*)d_in[10];
    a.qgain = (const float*)d_in[11]; a.kgain = (const float*)d_in[12]; a.rpb = (const float*)d_in[13]; a.sgwin = (const float*)d_in[14]; a.sgbin = (const float*)d_in[15];
    a.sgvgain = (const float*)d_in[16]; a.sgws = (const float*)d_in[17]; a.sgbs = (const float*)d_in[18]; a.sgwout = (const float*)d_in[19];
    a.out = (float*)d_out; a.ws = (unsigned char*)d_ws;
#if MK_PER_PHASE
    for (int p = 0; p < N_PHASES; ++p) { a.ph_lo = p; a.ph_hi = p + 1; hipLaunchKernelGGL(fwd_kernel, dim3(grid), dim3(NWAVES * 64), LDS_BYTES, stream, a); }
#else
    a.ph_lo = 0; a.ph_hi = N_PHASES; hipLaunchKernelGGL(fwd_kernel, dim3(grid), dim3(NWAVES * 64), LDS_BYTES, stream, a);
#endif
    const hipError_t le = hipPeekAtLastError();
    if (le != hipSuccess) fprintf(stderr, "kernel_launch: launch failed: %s\n", hipGetErrorName(le));
}
```
